# Optimizing an MI355X kernel written in HIP

```python
import math
import jax, jax.numpy as jnp
from jax import lax
import numpy as np

D_MODEL = 2048
BATCH = 4
SEQ = 8192
DEPTH = 2

HEAD_DIM = 128
N_HGRN_HEADS = 8
HGRN_KEY_DIM = 128
HGRN_VAL_DIM = HEAD_DIM
HGRN_WIDTH = N_HGRN_HEADS * HGRN_VAL_DIM
HGRN_CHUNK = 64
N_ATTN_HEADS = 8
ATTN_WIDTH = N_ATTN_HEADS * HEAD_DIM
MIX_WIDTH = HGRN_WIDTH + ATTN_WIDTH
ATTN_BLOCK = 128
DILATED_PAIRS = ((128, 1), (512, 4), (2048, 16))
ROT_DIM = HEAD_DIM // 4
ROPE_THETA = 500000.0
D_FF = 4 * D_MODEL
PLE_DIM = 256
NORM_EPS = 1e-6
IN_COLS = 2 * N_HGRN_HEADS * HGRN_KEY_DIM + 2 * HGRN_WIDTH + 3 * ATTN_WIDTH

kernel_name = "hymba_hgrn2_dilated_attn_trunk"


def rmsnorm(x, gain):
    xf = x.astype(jnp.float32)
    y = xf * lax.rsqrt(jnp.mean(xf * xf, axis=-1, keepdims=True) + NORM_EPS)
    return (y * gain.astype(jnp.float32)).astype(x.dtype)


def rotary_tables(positions):
    inv_freq = 1.0 / (ROPE_THETA ** (jnp.arange(0, ROT_DIM, 2, dtype=jnp.float32) / ROT_DIM))
    ang = positions.astype(jnp.float32)[..., None] * inv_freq
    return jnp.cos(ang)[:, None], jnp.sin(ang)[:, None]


def apply_partial_rotary(x, cos, sin):
    xf = x.astype(jnp.float32)
    half = ROT_DIM // 2
    x1, x2, xp = xf[..., :half], xf[..., half:ROT_DIM], xf[..., ROT_DIM:]
    return jnp.concatenate([x1 * cos - x2 * sin, x2 * cos + x1 * sin, xp], axis=-1)


def hgrn2_mixer(zq, zf, zi, zg, lb, g_norm):
    B, T, _ = zq.shape
    H, K, V, C = N_HGRN_HEADS, HGRN_KEY_DIM, HGRN_VAL_DIM, HGRN_CHUNK

    def heads(a, dim):
        return a.reshape(B, T, H, dim).transpose(0, 2, 1, 3).astype(jnp.float32)

    q = jax.nn.silu(heads(zq, K))
    xf = heads(zf, K)
    v = heads(zi, V)
    lbh = lb.reshape(H, 1, K).astype(jnp.float32)
    log_f = jnp.logaddexp(jnp.log(lbh), jnp.log1p(-lbh) + jax.nn.log_sigmoid(xf))
    k = (1.0 - lbh) * jax.nn.sigmoid(-xf)

    NC = T // C

    def chunks(a):
        return jnp.moveaxis(a.reshape(B, H, NC, C, a.shape[-1]), 2, 0)

    tril = jnp.tril(jnp.ones((C, C), dtype=bool))[:, :, None]

    def step(S, inp):
        qc, kc, vc, lfc = inp
        b = jnp.cumsum(lfc, axis=-2)
        diff = b[:, :, :, None, :] - b[:, :, None, :, :]
        decay = jnp.exp(jnp.where(tril, diff, -jnp.inf))
        A = jnp.einsum('bhtk,bhtsk,bhsk->bhts', qc, decay, kc)
        o = jnp.einsum('bhts,bhsv->bhtv', A, vc) + jnp.einsum('bhtk,bhkv->bhtv', qc * jnp.exp(b), S)
        bC = b[:, :, -1:, :]
        S = jnp.exp(bC[:, :, 0, :])[..., None] * S + jnp.einsum('bhsk,bhsv->bhkv', kc * jnp.exp(bC - b), vc)
        return S, o

    S0 = jnp.zeros((B, H, K, V), jnp.float32)
    _, o = lax.scan(step, S0, (chunks(q), chunks(k), chunks(v), chunks(log_f)))
    o = jnp.moveaxis(o, 0, 2).reshape(B, H, T, V)
    o = rmsnorm(o, g_norm)
    o = o.transpose(0, 2, 1, 3).reshape(B, T, H * V)
    return (o * jax.nn.silu(zg.astype(jnp.float32))).astype(zq.dtype)


def dilated_branch(q, k, v, window, dilation):
    B, H, T, E = q.shape
    Q = ATTN_BLOCK
    W = window // dilation
    span = dilation * Q
    T_pad = -(-T // span) * span
    N = T_pad // dilation
    NB = N // Q

    def to_blocks(a):
        a = jnp.pad(a, ((0, 0), (0, 0), (0, T_pad - T), (0, 0)))
        a = a.reshape(B, H, N, dilation, E).transpose(0, 1, 3, 2, 4)
        return a.reshape(B, H, dilation, NB, Q, E)

    def with_prev(a):
        prev = jnp.pad(a[:, :, :, :-1], ((0, 0), (0, 0), (0, 0), (1, 0), (0, 0), (0, 0)))
        return jnp.concatenate([prev, a], axis=-2)

    qb = to_blocks(q)
    kc = with_prev(to_blocks(k))
    vc = with_prev(to_blocks(v))
    s = jnp.einsum('bhrnqe,bhrnke->bhrnqk', qb, kc)
    qi = jnp.arange(Q)[:, None]
    kj = jnp.arange(2 * Q)[None, :]
    dist = qi + Q - kj
    band = (dist >= 0) & (dist <= W)
    first = (jnp.arange(NB) == 0)[:, None, None]
    valid = band[None] & ~(first & (kj < Q)[None])
    s = jnp.where(valid, s, -jnp.inf)
    m = jnp.max(s, axis=-1, keepdims=True)
    e = jnp.exp(s - m)
    den = jnp.sum(e, axis=-1)
    o = jnp.einsum('bhrnqk,bhrnke->bhrnqe', e, vc) / den[..., None]

    def from_blocks(a):
        tail = a.shape[5:]
        a = a.reshape((B, H, dilation, N) + tail)
        a = jnp.moveaxis(a, 2, 3).reshape((B, H, T_pad) + tail)
        return a[:, :, :T]

    return from_blocks(o), from_blocks(m[..., 0]), from_blocks(den)


def dilated_attention_mixer(zq, zk, zv, cos, sin, attn_norm):
    B, T, _ = zq.shape
    H = N_ATTN_HEADS

    def heads(a):
        return a.reshape(B, T, H, HEAD_DIM).transpose(0, 2, 1, 3)

    q = apply_partial_rotary(heads(zq), cos, sin) * (HEAD_DIM ** -0.5)
    k = apply_partial_rotary(heads(zk), cos, sin)
    v = heads(zv).astype(jnp.float32)
    outs = [dilated_branch(q, k, v, w, d) for (w, d) in DILATED_PAIRS]
    m_all = jnp.stack([m for (_, m, _) in outs], axis=0)
    m_max = jnp.max(m_all, axis=0)
    wts = jnp.stack([den * jnp.exp(m - m_max) for (_, m, den) in outs], axis=0)
    o_all = jnp.stack([o for (o, _, _) in outs], axis=0)
    o = jnp.sum(wts[..., None] * o_all, axis=0) / jnp.sum(wts, axis=0)[..., None]
    o = rmsnorm(o, attn_norm)
    return o.transpose(0, 2, 1, 3).reshape(B, T, H * HEAD_DIM).astype(zq.dtype)


def setup_inputs(seed: int = 0) -> dict:
    key = jax.random.key(seed)
    ks = jax.random.split(key, 18)
    f32 = jnp.float32

    def nrm(k, shape, scale):
        return jax.random.normal(k, shape, f32) * scale

    def gain(k, shape):
        return 1.0 + 0.02 * jax.random.normal(k, shape, f32)

    x = jax.random.normal(ks[0], (BATCH, SEQ, D_MODEL), f32)
    p = jax.random.normal(ks[1], (DEPTH, BATCH, SEQ, PLE_DIM), f32)
    offset = jax.random.randint(ks[2], (BATCH, 1), 0, 4096, dtype=jnp.int32)
    positions = (offset + jnp.arange(SEQ, dtype=jnp.int32)[None, :]).astype(jnp.int32)
    return {
        "x": x,
        "p": p,
        "positions": positions,
        "norm1": gain(ks[3], (DEPTH, D_MODEL)),
        "w_in": nrm(ks[4], (DEPTH, D_MODEL, IN_COLS), D_MODEL ** -0.5),
        "lb_param": nrm(ks[5], (DEPTH, N_HGRN_HEADS * HGRN_KEY_DIM), 0.5),
        "hgrn_norm": gain(ks[6], (DEPTH, HGRN_VAL_DIM)),
        "attn_norm": gain(ks[7], (DEPTH, HEAD_DIM)),
        "w_out": nrm(ks[8], (DEPTH, MIX_WIDTH, D_MODEL), MIX_WIDTH ** -0.5),
        "norm2": gain(ks[9], (DEPTH, D_MODEL)),
        "w1": nrm(ks[10], (DEPTH, D_MODEL, D_FF), D_MODEL ** -0.5),
        "w2": nrm(ks[11], (DEPTH, D_FF, D_MODEL), D_FF ** -0.5),
        "ple_norm": gain(ks[12], (DEPTH, D_MODEL)),
        "w_pg": nrm(ks[13], (DEPTH, D_MODEL, D_MODEL), D_MODEL ** -0.5),
        "w_pp": nrm(ks[14], (DEPTH, PLE_DIM, D_MODEL), PLE_DIM ** -0.5),
        "final_norm": gain(ks[15], (D_MODEL,)),
    }


def reference(x, p, positions, norm1, w_in, lb_param, hgrn_norm, attn_norm, w_out,
              norm2, w1, w2, ple_norm, w_pg, w_pp, final_norm):
    cos, sin = rotary_tables(positions)
    lbs = jnp.cumsum(jax.nn.softmax(lb_param.astype(jnp.float32), axis=0), axis=0)
    lbs = lbs - lbs[0:1]
    FK = N_HGRN_HEADS * HGRN_KEY_DIM
    splits = np.cumsum([FK, FK, HGRN_WIDTH, HGRN_WIDTH, ATTN_WIDTH, ATTN_WIDTH]).tolist()
    h = x
    for i in range(DEPTH):
        u = rmsnorm(h, norm1[i])
        z = jnp.einsum('btd,dc->btc', u, w_in[i])
        hq, hf, hi, hg, aq, ak, av = jnp.split(z, splits, axis=-1)
        o_hgrn = hgrn2_mixer(hq, hf, hi, hg, lbs[i], hgrn_norm[i])
        o_attn = dilated_attention_mixer(aq, ak, av, cos, sin, attn_norm[i])
        mix = jnp.concatenate([o_hgrn, o_attn], axis=-1)
        h = h + jnp.einsum('btc,cd->btd', mix, w_out[i])
        u2 = rmsnorm(h, norm2[i])
        a = jax.nn.relu(jnp.einsum('btd,df->btf', u2, w1[i]))
        h = h + jnp.einsum('btf,fd->btd', a * a, w2[i])
        gate = jax.nn.sigmoid(jnp.einsum('btd,de->bte', rmsnorm(h, ple_norm[i]), w_pg[i]))
        h = h + jnp.einsum('btk,kd->btd', p[i], w_pp[i]) * gate
    return rmsnorm(h, final_norm)
```

```cpp
#include <hip/hip_runtime.h>
#include <hip/hip_cooperative_groups.h>
#include <cstdio>
namespace cg = cooperative_groups;

#define LAS __attribute__((address_space(3)))
typedef unsigned short bf16_t;
typedef short bf16x8 __attribute__((ext_vector_type(8)));
typedef float f32x4 __attribute__((ext_vector_type(4)));
typedef float f32x2 __attribute__((ext_vector_type(2)));
typedef unsigned u32x4 __attribute__((ext_vector_type(4)));
typedef unsigned u32x2 __attribute__((ext_vector_type(2)));

constexpr int NTOK = 32768, DM = 2048, INC = 7168, DFF = 8192, PLE = 256, SEQ = 8192;
constexpr float EPS = 1e-6f;
constexpr int LDS_BYTES = 137216;

constexpr size_t SZ_WIN = (size_t)INC * DM * 2, SZ_WOUT = (size_t)DM * DM * 2, SZ_W1 = (size_t)DFF * DM * 2, SZ_W2 = SZ_W1, SZ_WPG = SZ_WOUT, SZ_WPP = (size_t)DM * PLE * 2;
constexpr size_t WO_IN = 0, WO_OUT = WO_IN + SZ_WIN, WO_1 = WO_OUT + SZ_WOUT, WO_2 = WO_1 + SZ_W1, WO_PG = WO_2 + SZ_W2, WO_PP = WO_PG + SZ_WPG, SZ_WL = WO_PP + SZ_WPP;
constexpr size_t OFF_W = 0;
constexpr size_t OFF_HB0 = OFF_W + 2 * SZ_WL;
constexpr size_t SZ_HB = (size_t)NTOK * DM * 2;
constexpr size_t OFF_G = OFF_HB0 + SZ_HB;
constexpr size_t SZ_Z = (size_t)NTOK * INC * 2;
constexpr size_t OFF_MIX = OFF_G + SZ_Z;
constexpr size_t OFF_ACT = OFF_G;
constexpr size_t OFF_PP = OFF_G + (size_t)16384 * DFF * 2;
constexpr size_t OFF_PB = OFF_MIX + SZ_HB;
constexpr size_t SZ_PB = 2ull * NTOK * PLE * 2;
constexpr size_t OFF_CS = OFF_PB + SZ_PB;
constexpr size_t SZ_CS = 2ull * NTOK * 16 * 4;
constexpr size_t OFF_ML = OFF_CS + SZ_CS;
constexpr size_t SZ_ML = 3ull * NTOK * 8 * 8;
constexpr size_t OFF_SS = OFF_ML + SZ_ML;
constexpr size_t SZ_SS = 7ull * NTOK * 4;
constexpr size_t WS_END = OFF_SS + SZ_SS;
static_assert(OFF_PP + SZ_HB <= OFF_MIX, "PP overlaps mix");

struct Params {
    const float* x; const float* p; const int* pos;
    const float* norm1; const float* w_in; const float* lb; const float* hgrn_norm; const float* attn_norm; const float* w_out;
    const float* norm2; const float* w1; const float* w2; const float* ple_norm; const float* w_pg; const float* w_pp; const float* final_norm;
    float* out; unsigned char* ws;
};

__device__ __forceinline__ unsigned cvt_pk_bf16(float lo, float hi) { unsigned r; asm volatile("v_cvt_pk_bf16_f32 %0, %1, %2" : "=v"(r) : "v"(lo), "v"(hi)); return r; }
__device__ __forceinline__ float bf_lo(unsigned u) { return __uint_as_float(u << 16); }
__device__ __forceinline__ float bf_hi(unsigned u) { return __uint_as_float(u & 0xffff0000u); }
__device__ __forceinline__ float bf2f(bf16_t b) { return __uint_as_float(((unsigned)b) << 16); }
__device__ __forceinline__ bf16_t f2bf(float f) { return (bf16_t)(cvt_pk_bf16(f, 0.f) & 0xffffu); }
__device__ __forceinline__ float sigmoidf_(float v) { return 1.0f / (1.0f + __expf(-v)); }
__device__ __forceinline__ float siluf_(float v) { return v / (1.0f + __expf(-v)); }
__device__ __forceinline__ float wave_sum(float v) {
    v += __shfl_xor(v, 32); v += __shfl_xor(v, 16); v += __shfl_xor(v, 8); v += __shfl_xor(v, 4); v += __shfl_xor(v, 2); v += __shfl_xor(v, 1); return v;
}
__device__ __forceinline__ void atomic_addf(float* p, float v) { __hip_atomic_fetch_add(p, v, __ATOMIC_RELAXED, __HIP_MEMORY_SCOPE_AGENT); }

namespace pg8 {
constexpr int BM = 256, BK = 64, HALF = 128, HTB = HALF * BK * 2, STAGE_BYTES = 8 * HTB, NXCD = 8, WGM = 8;
__host__ __device__ __forceinline__ int lds_byte(int r, int c) { const int st = (r >> 4) * 2 + (c >> 5), rr = r & 15, cc = c & 31, ob = rr * 64 + cc * 2; return st * 1024 + (ob ^ (((ob >> 9) & 1) << 5)); }
__host__ __device__ __forceinline__ void stage_rc(int b, int& R, int& C) { const int st = b / 1024, sb = b % 1024, swz = sb ^ (((sb >> 9) & 1) << 5); R = (st >> 1) * 16 + swz / 64; C = (st & 1) * 32 + (swz % 64) / 2; }
__host__ __device__ __forceinline__ int perm32(int rho) { const int n = rho >> 4, i = rho & 15; return 8 * (i >> 2) + 4 * n + (i & 3); }
struct Unit { int pm, pn; };
struct Gemm { const bf16_t* A; const bf16_t* Bt; int M, N, K; };
struct StaticOrder {
    int nM, nN, nwg, G, c;
    __device__ void init(int M, int N, int G_, int c_) { nM = M / BM; nN = N / BM; nwg = nM * nN; G = G_; asm volatile("" : "+s"(c_)); c = c_; }
    __device__ bool next(int i, Unit& u) const {
        const long L = (long)i * G + c; if (L >= nwg) return false;
        int wgid = (int)L; { const int q = nwg / NXCD, r = nwg % NXCD, xcd = wgid % NXCD, off = wgid / NXCD; wgid = (xcd < r ? xcd * (q + 1) : r * (q + 1) + (xcd - r) * q) + off; }
        const int nig = WGM * nN, gid = wgid / nig, fm = gid * WGM, gsz = (nM - fm) < WGM ? (nM - fm) : WGM;
        u.pm = fm + ((wgid % nig) % gsz); u.pn = (wgid % nig) / gsz; return true;
    }
};

template <class Epi>
__device__ __forceinline__ void gemm_phase(LAS unsigned char* lds, const Gemm g, const StaticOrder& S, const Epi& E) {
    int tid = threadIdx.x; asm volatile("" : "+v"(tid));
    const int wid = __builtin_amdgcn_readfirstlane(tid >> 6), lane = tid & 63, wr = wid >> 2, wc = wid & 3, fr = lane & 15, fq = lane >> 4;
    const int K = g.K, nt = K / BK;
    unsigned voffA[2], voffB[2];
#pragma unroll
    for (int i = 0; i < 2; ++i) { int R, C; stage_rc(tid * 16 + i * 8192, R, C); const int Rb = (R & ~31) + perm32(R & 31);
        voffA[i] = (unsigned)(R * K + C) * 2u; voffB[i] = (unsigned)(Rb * K + C) * 2u; }
    const size_t kstep = (size_t)(BK * 2);
    const size_t hstep = (size_t)HALF * K * 2;
    const size_t tstep = 2 * hstep;
    const unsigned ldsw = (unsigned)wid * 1024u;
    const int aoff = lds_byte(wr * 64 + fr, fq * 8), boff = lds_byte(wc * 32 + fr, fq * 8);
#define PG8_SA(b, h) (((b) * 2 + (h)) * HTB)
#define PG8_SB(b, h) ((4 + (b) * 2 + (h)) * HTB)
#define PG8_STAGE(bufoff, gbase, voff) do { _Pragma("unroll") for (int _i = 0; _i < 2; ++_i) \
        __builtin_amdgcn_global_load_lds((const unsigned*)((const char*)(gbase) + (voff)[_i]), (LAS unsigned*)(lds + (bufoff) + ldsw + _i * 8192), 16, 0, 0); } while (0)
#define PG8_LDA(dst, b, h) do { _Pragma("unroll") for (int m = 0; m < 4; ++m) _Pragma("unroll") for (int k = 0; k < 2; ++k) dst[m][k] = *(const LAS bf16x8*)(lds + PG8_SA(b, h) + aoff + m * 2048 + k * 1024); } while (0)
#define PG8_LDB(dst, b, h) do { _Pragma("unroll") for (int n = 0; n < 2; ++n) _Pragma("unroll") for (int k = 0; k < 2; ++k) dst[n][k] = *(const LAS bf16x8*)(lds + PG8_SB(b, h) + boff + n * 2048 + k * 1024); } while (0)
#define PG8_MMA(ai, bj, At, Bt) do { __builtin_amdgcn_s_setprio(1); _Pragma("unroll") for (int m = 0; m < 4; ++m) _Pragma("unroll") for (int n = 0; n < 2; ++n) _Pragma("unroll") for (int k = 0; k < 2; ++k) \
        acc[ai][bj][m][n] = __builtin_amdgcn_mfma_f32_16x16x32_bf16(Bt[n][k], At[m][k], acc[ai][bj][m][n], 0, 0, 0); __builtin_amdgcn_s_setprio(0); } while (0)
#define PG8_WAIT_V(n) asm volatile("s_waitcnt vmcnt(" #n ")" ::: "memory")
#define PG8_WAIT_L(n) asm volatile("s_waitcnt lgkmcnt(" #n ")" ::: "memory")
#define PG8_BAR __builtin_amdgcn_s_barrier()
#define PG8_SCHED __builtin_amdgcn_sched_barrier(0)
    Unit cur, nxt; int ui = 0;
    if (!S.next(0, cur)) return;
    f32x4 acc[2][2][4][2];
#pragma unroll
    for (int a = 0; a < 2; ++a)
#pragma unroll
        for (int b = 0; b < 2; ++b)
#pragma unroll
            for (int m = 0; m < 4; ++m)
#pragma unroll
                for (int n = 0; n < 2; ++n) acc[a][b][m][n] = (f32x4){0.f, 0.f, 0.f, 0.f};
    bf16x8 At[4][2], B0[2][2], B1[2][2];
    const char* cA = (const char*)g.A + (size_t)cur.pm * tstep; const char* cB = (const char*)g.Bt + (size_t)cur.pn * tstep;
    PG8_STAGE(PG8_SB(0, 0), cB, voffB); PG8_STAGE(PG8_SA(0, 0), cA, voffA); PG8_STAGE(PG8_SB(0, 1), cB + hstep, voffB); PG8_STAGE(PG8_SA(0, 1), cA + hstep, voffA);
    if (wr == 1) PG8_BAR;
    PG8_WAIT_V(4); PG8_BAR;
    PG8_STAGE(PG8_SB(1, 0), cB + kstep, voffB); PG8_STAGE(PG8_SA(1, 0), cA + kstep, voffA); PG8_STAGE(PG8_SB(1, 1), cB + hstep + kstep, voffB);
    PG8_WAIT_V(6); PG8_BAR;
    for (;;) {
        const bool has_next = S.next(ui + 1, nxt);
        const char* nA = has_next ? (const char*)g.A + (size_t)nxt.pm * tstep : cA; const char* nB = has_next ? (const char*)g.Bt + (size_t)nxt.pn * tstep : cB;
        for (int t = 0; t < nt; t += 2) {
            const bool last = (t == nt - 2);
            const char* a1 = cA + (size_t)(t + 1) * kstep;
            const char* a2 = last ? nA : cA + (size_t)(t + 2) * kstep; const char* b2 = last ? nB : cB + (size_t)(t + 2) * kstep;
            const char* a3 = a2 + kstep; const char* b3 = b2 + kstep;
            PG8_LDB(B0, 0, 0); PG8_SCHED; PG8_LDA(At, 0, 0); PG8_STAGE(PG8_SA(1, 1), a1 + hstep, voffA);
            PG8_WAIT_L(8); PG8_BAR; PG8_WAIT_L(0); PG8_MMA(0, 0, At, B0); PG8_BAR; PG8_SCHED;
            PG8_LDB(B1, 0, 1); PG8_STAGE(PG8_SB(0, 0), b2, voffB);
            PG8_BAR; PG8_WAIT_L(0); PG8_MMA(0, 1, At, B1); PG8_BAR;
            PG8_LDA(At, 0, 1); PG8_STAGE(PG8_SA(0, 0), a2, voffA);
            PG8_BAR; PG8_WAIT_L(0); PG8_MMA(1, 0, At, B0); PG8_BAR; PG8_SCHED;
            PG8_STAGE(PG8_SB(0, 1), b2 + hstep, voffB);
            PG8_WAIT_V(6); PG8_BAR; PG8_MMA(1, 1, At, B1); PG8_BAR;
            PG8_LDB(B0, 1, 0); PG8_SCHED; PG8_LDA(At, 1, 0); PG8_STAGE(PG8_SA(0, 1), a2 + hstep, voffA);
            PG8_WAIT_L(8); PG8_BAR; PG8_WAIT_L(0); PG8_MMA(0, 0, At, B0); PG8_BAR; PG8_SCHED;
            PG8_LDB(B1, 1, 1); PG8_STAGE(PG8_SB(1, 0), b3, voffB);
            PG8_BAR; PG8_WAIT_L(0); PG8_MMA(0, 1, At, B1); PG8_BAR;
            PG8_LDA(At, 1, 1); PG8_STAGE(PG8_SA(1, 0), a3, voffA);
            PG8_BAR; PG8_WAIT_L(0); PG8_MMA(1, 0, At, B0); PG8_BAR; PG8_SCHED;
            PG8_STAGE(PG8_SB(1, 1), b3 + hstep, voffB);
            PG8_WAIT_V(6); PG8_BAR; PG8_MMA(1, 1, At, B1); PG8_BAR;
        }
        E(acc, cur, wr, wc, fr, fq);
        if (!has_next) break;
#pragma unroll
        for (int a = 0; a < 2; ++a)
#pragma unroll
            for (int b = 0; b < 2; ++b)
#pragma unroll
                for (int m = 0; m < 4; ++m)
#pragma unroll
                    for (int n = 0; n < 2; ++n) acc[a][b][m][n] = (f32x4){0.f, 0.f, 0.f, 0.f};
        cur = nxt; cA = nA; cB = nB; ++ui;
    }
    PG8_WAIT_V(0);
    if (wr == 0) PG8_BAR;
    PG8_BAR;
#undef PG8_SA
#undef PG8_SB
#undef PG8_STAGE
#undef PG8_LDA
#undef PG8_LDB
#undef PG8_MMA
#undef PG8_WAIT_V
#undef PG8_WAIT_L
#undef PG8_BAR
#undef PG8_SCHED
}
}
using pg8::Unit;

struct EpiIn {
    bf16_t* Z; const float* ss; const float* cosT; const float* sinT;
    __device__ __forceinline__ void operator()(const f32x4 (&acc)[2][2][4][2], const Unit& u, int wr, int wc, int fr_in, int fq_in) const {
        int fr = fr_in, fq = fq_in; asm volatile("" : "+v"(fr), "+v"(fq));
        const int row0 = u.pm * 256 + wr * 64 + fr, col0 = u.pn * 256 + wc * 32 + 8 * fq;
        const int typ = u.pn >> 2;
        const bool rot = (typ == 4 || typ == 5) && (wc == 0);
        const float sgn = (fq < 2) ? -1.0f : 1.0f;
#pragma unroll
        for (int ai = 0; ai < 2; ++ai)
#pragma unroll
            for (int m = 0; m < 4; ++m) {
                __builtin_amdgcn_sched_barrier(0);
                const int row = row0 + ai * 128 + m * 16;
                const float rs = rsqrtf(ss[row] * (1.0f / DM) + EPS);
                f32x4 c0 = (f32x4){1.f, 1.f, 1.f, 1.f}, c1 = c0, s0 = (f32x4){0.f, 0.f, 0.f, 0.f}, s1 = s0;
                if (rot) { const float* cp = cosT + (size_t)row * 16 + 8 * (fq & 1); const float* sp = sinT + (size_t)row * 16 + 8 * (fq & 1);
                    c0 = *(const f32x4*)cp; c1 = *(const f32x4*)(cp + 4); s0 = *(const f32x4*)sp; s1 = *(const f32x4*)(sp + 4); }
                bf16_t* rowp = Z + (size_t)row * INC + col0;
#pragma unroll
                for (int bj = 0; bj < 2; ++bj) {
                    f32x4 v0 = acc[ai][bj][m][0] * rs, v1 = acc[ai][bj][m][1] * rs;
                    if (typ == 0 || typ == 3) {
#pragma unroll
                        for (int j = 0; j < 4; ++j) { v0[j] = siluf_(v0[j]); v1[j] = siluf_(v1[j]); }
                    }
                    if (rot) {
                        f32x4 p0, p1;
#pragma unroll
                        for (int j = 0; j < 4; ++j) { p0[j] = __shfl_xor(v0[j], 32); p1[j] = __shfl_xor(v1[j], 32); }
                        v0 = v0 * c0 + (p0 * s0) * sgn; v1 = v1 * c1 + (p1 * s1) * sgn;
                    }
                    if (typ == 4) { v0 = v0 * 0.08838834764831845f; v1 = v1 * 0.08838834764831845f; }
                    u32x4 w; w.x = cvt_pk_bf16(v0[0], v0[1]); w.y = cvt_pk_bf16(v0[2], v0[3]); w.z = cvt_pk_bf16(v1[0], v1[1]); w.w = cvt_pk_bf16(v1[2], v1[3]);
                    *(u32x4*)(rowp + bj * 128) = w;
                }
            }
    }
};
struct EpiRes {
    const float* hin; float* hout; bf16_t* hb; float* ssacc; int row_off;
    __device__ __forceinline__ void operator()(const f32x4 (&acc)[2][2][4][2], const Unit& u, int wr, int wc, int fr_in, int fq_in) const {
        int fr = fr_in, fq = fq_in; asm volatile("" : "+v"(fr), "+v"(fq));
        const int row0 = row_off + u.pm * 256 + wr * 64 + fr, col0 = u.pn * 256 + wc * 32 + 8 * fq;
#pragma unroll
        for (int ai = 0; ai < 2; ++ai)
#pragma unroll
            for (int m = 0; m < 4; ++m) {
                __builtin_amdgcn_sched_barrier(0);
                const int row = row0 + ai * 128 + m * 16;
                float sq = 0.f;
#pragma unroll
                for (int bj = 0; bj < 2; ++bj) {
                    const size_t o = (size_t)row * DM + col0 + bj * 128;
                    f32x4 h0 = *(const f32x4*)(hin + o), h1 = *(const f32x4*)(hin + o + 4);
                    h0 = h0 + acc[ai][bj][m][0]; h1 = h1 + acc[ai][bj][m][1];
                    *(f32x4*)(hout + o) = h0; *(f32x4*)(hout + o + 4) = h1;
                    sq += h0[0] * h0[0] + h0[1] * h0[1] + h0[2] * h0[2] + h0[3] * h0[3] + h1[0] * h1[0] + h1[1] * h1[1] + h1[2] * h1[2] + h1[3] * h1[3];
                    u32x4 w; w.x = cvt_pk_bf16(h0[0], h0[1]); w.y = cvt_pk_bf16(h0[2], h0[3]); w.z = cvt_pk_bf16(h1[0], h1[1]); w.w = cvt_pk_bf16(h1[2], h1[3]);
                    *(u32x4*)(hb + o) = w;
                }
                sq += __shfl_xor(sq, 16); sq += __shfl_xor(sq, 32);
                if (fq == 0) atomic_addf(ssacc + row, sq);
            }
    }
};
struct EpiAct {
    bf16_t* act; const float* ss; int row_off;
    __device__ __forceinline__ void operator()(const f32x4 (&acc)[2][2][4][2], const Unit& u, int wr, int wc, int fr_in, int fq_in) const {
        int fr = fr_in, fq = fq_in; asm volatile("" : "+v"(fr), "+v"(fq));
        const int row0 = u.pm * 256 + wr * 64 + fr, col0 = u.pn * 256 + wc * 32 + 8 * fq;
#pragma unroll
        for (int ai = 0; ai < 2; ++ai)
#pragma unroll
            for (int m = 0; m < 4; ++m) {
                __builtin_amdgcn_sched_barrier(0);
                const int row = row0 + ai * 128 + m * 16;
                const float rs = rsqrtf(ss[row_off + row] * (1.0f / DM) + EPS);
#pragma unroll
                for (int bj = 0; bj < 2; ++bj) {
                    f32x4 v0 = acc[ai][bj][m][0] * rs, v1 = acc[ai][bj][m][1] * rs;
#pragma unroll
                    for (int j = 0; j < 4; ++j) { const float a = fmaxf(v0[j], 0.f), b = fmaxf(v1[j], 0.f); v0[j] = a * a; v1[j] = b * b; }
                    u32x4 w; w.x = cvt_pk_bf16(v0[0], v0[1]); w.y = cvt_pk_bf16(v0[2], v0[3]); w.z = cvt_pk_bf16(v1[0], v1[1]); w.w = cvt_pk_bf16(v1[2], v1[3]);
                    *(u32x4*)(act + (size_t)row * DFF + col0 + bj * 128) = w;
                }
            }
    }
};
struct EpiPP {
    bf16_t* O;
    __device__ __forceinline__ void operator()(const f32x4 (&acc)[2][2][4][2], const Unit& u, int wr, int wc, int fr_in, int fq_in) const {
        int fr = fr_in, fq = fq_in; asm volatile("" : "+v"(fr), "+v"(fq));
        const int row0 = u.pm * 256 + wr * 64 + fr, col0 = u.pn * 256 + wc * 32 + 8 * fq;
#pragma unroll
        for (int ai = 0; ai < 2; ++ai)
#pragma unroll
            for (int m = 0; m < 4; ++m) {
                __builtin_amdgcn_sched_barrier(0);
                const int row = row0 + ai * 128 + m * 16;
#pragma unroll
                for (int bj = 0; bj < 2; ++bj) {
                    const f32x4 v0 = acc[ai][bj][m][0], v1 = acc[ai][bj][m][1];
                    u32x4 w; w.x = cvt_pk_bf16(v0[0], v0[1]); w.y = cvt_pk_bf16(v0[2], v0[3]); w.z = cvt_pk_bf16(v1[0], v1[1]); w.w = cvt_pk_bf16(v1[2], v1[3]);
                    *(u32x4*)(O + (size_t)row * DM + col0 + bj * 128) = w;
                }
            }
    }
};
struct EpiPle {
    float* h; bf16_t* hb; const bf16_t* PP; const float* ss; float* ssacc;
    __device__ __forceinline__ void operator()(const f32x4 (&acc)[2][2][4][2], const Unit& u, int wr, int wc, int fr_in, int fq_in) const {
        int fr = fr_in, fq = fq_in; asm volatile("" : "+v"(fr), "+v"(fq));
        const int row0 = u.pm * 256 + wr * 64 + fr, col0 = u.pn * 256 + wc * 32 + 8 * fq;
#pragma unroll
        for (int ai = 0; ai < 2; ++ai)
#pragma unroll
            for (int m = 0; m < 4; ++m) {
                __builtin_amdgcn_sched_barrier(0);
                const int row = row0 + ai * 128 + m * 16;
                const float rs = rsqrtf(ss[row] * (1.0f / DM) + EPS);
                float sq = 0.f;
#pragma unroll
                for (int bj = 0; bj < 2; ++bj) {
                    const size_t o = (size_t)row * DM + col0 + bj * 128;
                    f32x4 h0 = *(const f32x4*)(h + o), h1 = *(const f32x4*)(h + o + 4);
                    const u32x4 pp = *(const u32x4*)(PP + o);
                    f32x4 g0 = acc[ai][bj][m][0] * rs, g1 = acc[ai][bj][m][1] * rs;
#pragma unroll
                    for (int j = 0; j < 4; ++j) { g0[j] = sigmoidf_(g0[j]); g1[j] = sigmoidf_(g1[j]); }
                    h0[0] += bf_lo(pp.x) * g0[0]; h0[1] += bf_hi(pp.x) * g0[1]; h0[2] += bf_lo(pp.y) * g0[2]; h0[3] += bf_hi(pp.y) * g0[3];
                    h1[0] += bf_lo(pp.z) * g1[0]; h1[1] += bf_hi(pp.z) * g1[1]; h1[2] += bf_lo(pp.w) * g1[2]; h1[3] += bf_hi(pp.w) * g1[3];
                    *(f32x4*)(h + o) = h0; *(f32x4*)(h + o + 4) = h1;
                    sq += h0[0] * h0[0] + h0[1] * h0[1] + h0[2] * h0[2] + h0[3] * h0[3] + h1[0] * h1[0] + h1[1] * h1[1] + h1[2] * h1[2] + h1[3] * h1[3];
                    u32x4 w; w.x = cvt_pk_bf16(h0[0], h0[1]); w.y = cvt_pk_bf16(h0[2], h0[3]); w.z = cvt_pk_bf16(h1[0], h1[1]); w.w = cvt_pk_bf16(h1[2], h1[3]);
                    *(u32x4*)(hb + o) = w;
                }
                sq += __shfl_xor(sq, 16); sq += __shfl_xor(sq, 32);
                if (fq == 0) atomic_addf(ssacc + row, sq);
            }
    }
};

__device__ void transpose_job(LAS unsigned char* lds, const float* src, const float* gain, bf16_t* dst, int K, int N) {
    LAS float* tile = (LAS float*)lds;
    const int tid = threadIdx.x, tn = N >> 6, ntile = (K >> 6) * tn;
    for (int t = blockIdx.x; t < ntile; t += gridDim.x) {
        const int k0 = (t / tn) << 6, n0 = (t % tn) << 6;
#pragma unroll
        for (int i = 0; i < 2; ++i) {
            const int id = tid + 512 * i, kr = id >> 4, c4 = (id & 15) * 4;
            f32x4 v = *(const f32x4*)(src + (size_t)(k0 + kr) * N + n0 + c4);
            const float g = gain ? gain[k0 + kr] : 1.0f;
            tile[kr * 65 + c4 + 0] = v[0] * g; tile[kr * 65 + c4 + 1] = v[1] * g; tile[kr * 65 + c4 + 2] = v[2] * g; tile[kr * 65 + c4 + 3] = v[3] * g;
        }
        __syncthreads();
        {
            const int n = tid >> 3, kc = (tid & 7) * 8;
            float v[8];
#pragma unroll
            for (int j = 0; j < 8; ++j) v[j] = tile[(kc + j) * 65 + n];
            u32x4 w; w.x = cvt_pk_bf16(v[0], v[1]); w.y = cvt_pk_bf16(v[2], v[3]); w.z = cvt_pk_bf16(v[4], v[5]); w.w = cvt_pk_bf16(v[6], v[7]);
            *(u32x4*)(dst + (size_t)(n0 + n) * K + k0 + kc) = w;
        }
        __syncthreads();
    }
}

__device__ void prep_phase(const Params& P, LAS unsigned char* lds) {
    unsigned char* ws = P.ws;
    const int tid = threadIdx.x, lane = tid & 63, w = tid >> 6;
    for (int l = 0; l < 2; ++l) {
        unsigned char* wl = ws + OFF_W + (size_t)l * SZ_WL;
        transpose_job(lds, P.w_in + (size_t)l * DM * INC, P.norm1 + l * DM, (bf16_t*)(wl + WO_IN), DM, INC);
        transpose_job(lds, P.w_out + (size_t)l * DM * DM, nullptr, (bf16_t*)(wl + WO_OUT), DM, DM);
        transpose_job(lds, P.w1 + (size_t)l * DM * DFF, P.norm2 + l * DM, (bf16_t*)(wl + WO_1), DM, DFF);
        transpose_job(lds, P.w2 + (size_t)l * DFF * DM, nullptr, (bf16_t*)(wl + WO_2), DFF, DM);
        transpose_job(lds, P.w_pg + (size_t)l * DM * DM, P.ple_norm + l * DM, (bf16_t*)(wl + WO_PG), DM, DM);
        transpose_job(lds, P.w_pp + (size_t)l * PLE * DM, nullptr, (bf16_t*)(wl + WO_PP), PLE, DM);
    }
    {
        bf16_t* hb1 = (bf16_t*)(ws + OFF_MIX); float* ss0 = (float*)(ws + OFF_SS);
        for (int row = blockIdx.x * 8 + w; row < NTOK; row += gridDim.x * 8) {
            const float* xr = P.x + (size_t)row * DM; float sq = 0.f;
#pragma unroll
            for (int i = 0; i < 8; ++i) {
                const f32x4 v = *(const f32x4*)(xr + i * 256 + lane * 4);
                sq += v[0] * v[0] + v[1] * v[1] + v[2] * v[2] + v[3] * v[3];
                u32x2 o; o.x = cvt_pk_bf16(v[0], v[1]); o.y = cvt_pk_bf16(v[2], v[3]);
                *(u32x2*)(hb1 + (size_t)row * DM + i * 256 + lane * 4) = o;
            }
            sq = wave_sum(sq);
            if (lane == 0) ss0[row] = sq;
        }
    }
    const size_t gt = (size_t)blockIdx.x * 512 + tid, gn = (size_t)gridDim.x * 512;
    {
        bf16_t* pb = (bf16_t*)(ws + OFF_PB); const size_t n4 = 2ull * NTOK * PLE / 4;
        for (size_t i = gt; i < n4; i += gn) { const f32x4 v = *(const f32x4*)(P.p + i * 4); u32x2 o; o.x = cvt_pk_bf16(v[0], v[1]); o.y = cvt_pk_bf16(v[2], v[3]); *(u32x2*)(pb + i * 4) = o; }
    }
    {
        float* cosT = (float*)(ws + OFF_CS); float* sinT = cosT + (size_t)NTOK * 16;
        for (size_t i = gt; i < (size_t)NTOK * 16; i += gn) {
            const int tok = (int)(i >> 4), fi = (int)(i & 15);
            const float inv = 1.0f / powf(500000.0f, (float)fi * (1.0f / 16.0f));
            const float ang = (float)P.pos[tok] * inv;
            float s, c; sincosf(ang, &s, &c);
            cosT[i] = c; sinT[i] = s;
        }
    }
    {
        float* ss = (float*)(ws + OFF_SS) + NTOK;
        for (size_t i = gt; i < 6ull * NTOK; i += gn) ss[i] = 0.f;
    }
}

__device__ void hgrn_item(const Params& P, LAS unsigned char* lds, int item, int layer, const bf16_t* z, bf16_t* mixb) {
    int tid = threadIdx.x; asm volatile("" : "+v"(tid));
    const int lane = tid & 63, w = tid >> 6, v = lane & 15, kq = lane >> 4;
    const int b = item >> 6, hh = (item >> 3) & 7, vs = item & 7;
    LAS float* qs = (LAS float*)lds; LAS float* fs = qs + 64 * 128; LAS float* ks = fs + 64 * 128; LAS float* vsm = ks + 64 * 128; LAS float* op = vsm + 64 * 16;
    const int cc = tid & 15, rr = tid >> 4;
    float lbv[8];
#pragma unroll
    for (int j = 0; j < 8; ++j) {
        const int c = hh * 128 + cc * 8 + j;
        lbv[j] = (layer == 0) ? 0.f : 1.0f / (1.0f + expf(P.lb[c] - P.lb[1024 + c]));
    }
    const bf16_t* zb = z + (size_t)b * SEQ * INC;
    u32x4 rq[2], rx[2], rv = (u32x4){0u, 0u, 0u, 0u};
    auto issue = [&](int t0) {
#pragma unroll
        for (int i = 0; i < 2; ++i) {
            const bf16_t* rp = zb + (size_t)(t0 + rr + 32 * i) * INC + hh * 128 + cc * 8;
            rq[i] = *(const u32x4*)rp; rx[i] = *(const u32x4*)(rp + 1024);
        }
        if (tid < 128) rv = *(const u32x4*)(zb + (size_t)(t0 + (tid >> 1)) * INC + 2048 + hh * 128 + vs * 16 + (tid & 1) * 8);
    };
    issue(0);
    float s0 = 0.f, s1 = 0.f, s2 = 0.f, s3 = 0.f;
    const int kbase = 16 * w + 4 * kq;
    for (int ch = 0; ch < SEQ / 64; ++ch) {
#pragma unroll
        for (int i = 0; i < 2; ++i) {
            const int row = rr + 32 * i;
            const unsigned qa[4] = {rq[i].x, rq[i].y, rq[i].z, rq[i].w}, xa[4] = {rx[i].x, rx[i].y, rx[i].z, rx[i].w};
            f32x4 q0, q1, f0, f1, k0, k1;
#pragma unroll
            for (int j = 0; j < 4; ++j) {
                const float ql = bf_lo(qa[j]), qh = bf_hi(qa[j]), xl = bf_lo(xa[j]), xh = bf_hi(xa[j]);
                const float sl = 1.0f / (1.0f + expf(-xl)), sh = 1.0f / (1.0f + expf(-xh));
                const float nl = 1.0f / (1.0f + expf(xl)), nh = 1.0f / (1.0f + expf(xh));
                const float lbl = lbv[2 * j], lbh = lbv[2 * j + 1];
                const float fl = lbl + (1.0f - lbl) * sl, fh = lbh + (1.0f - lbh) * sh, kl = (1.0f - lbl) * nl, kh = (1.0f - lbh) * nh;
                if (j < 2) { q0[2 * j] = ql; q0[2 * j + 1] = qh; f0[2 * j] = fl; f0[2 * j + 1] = fh; k0[2 * j] = kl; k0[2 * j + 1] = kh; }
                else { q1[2 * j - 4] = ql; q1[2 * j - 3] = qh; f1[2 * j - 4] = fl; f1[2 * j - 3] = fh; k1[2 * j - 4] = kl; k1[2 * j - 3] = kh; }
            }
            const int o = row * 128 + cc * 8;
            *(LAS f32x4*)(qs + o) = q0; *(LAS f32x4*)(qs + o + 4) = q1;
            *(LAS f32x4*)(fs + o) = f0; *(LAS f32x4*)(fs + o + 4) = f1;
            *(LAS f32x4*)(ks + o) = k0; *(LAS f32x4*)(ks + o + 4) = k1;
        }
        if (tid < 128) {
            const int o = (tid >> 1) * 16 + (tid & 1) * 8;
            f32x4 a, c; a[0] = bf_lo(rv.x); a[1] = bf_hi(rv.x); a[2] = bf_lo(rv.y); a[3] = bf_hi(rv.y); c[0] = bf_lo(rv.z); c[1] = bf_hi(rv.z); c[2] = bf_lo(rv.w); c[3] = bf_hi(rv.w);
            *(LAS f32x4*)(vsm + o) = a; *(LAS f32x4*)(vsm + o + 4) = c;
        }
        __syncthreads();
        if (ch + 1 < SEQ / 64) issue((ch + 1) * 64);
#pragma unroll 16
        for (int t = 0; t < 64; ++t) {
            const f32x4 f = *(const LAS f32x4*)(fs + t * 128 + kbase), kk = *(const LAS f32x4*)(ks + t * 128 + kbase), q = *(const LAS f32x4*)(qs + t * 128 + kbase);
            const float vv = vsm[t * 16 + v];
            s0 = fmaf(f[0], s0, kk[0] * vv); s1 = fmaf(f[1], s1, kk[1] * vv); s2 = fmaf(f[2], s2, kk[2] * vv); s3 = fmaf(f[3], s3, kk[3] * vv);
            float o = q[0] * s0 + q[1] * s1 + q[2] * s2 + q[3] * s3;
            o += __shfl_xor(o, 16); o += __shfl_xor(o, 32);
            if (kq == 0) op[(t * 8 + w) * 16 + v] = o;
        }
        __syncthreads();
#pragma unroll
        for (int i = 0; i < 2; ++i) {
            const int idx = tid + 512 * i, t = idx >> 4, vv = idx & 15;
            float o = 0.f;
#pragma unroll
            for (int ww = 0; ww < 8; ++ww) o += op[(t * 8 + ww) * 16 + vv];
            mixb[(size_t)(b * SEQ + ch * 64 + t) * DM + hh * 128 + vs * 16 + vv] = f2bf(o);
        }
    }
    __syncthreads();
}

constexpr int KROW = 272, VROW = 528, VT_OFF = 256 * KROW;
__device__ void attn_item(LAS unsigned char* lds, int item, const bf16_t* z, bf16_t* mixb, bf16_t* part1, bf16_t* part2, f32x2* ml) {
    int tid = threadIdx.x; asm volatile("" : "+v"(tid));
    const int lane = tid & 63, w = tid >> 6, r16 = lane & 15, qq = lane >> 4;
    const int g = item >> 11, rem = item & 2047, bh = rem >> 6, blk = rem & 63, b = bh >> 3, hh = bh & 7;
    const int lg = 2 * g, d = 1 << lg, nbl = 6 - lg;
    const int res = blk >> nbl, n = blk & ((1 << nbl) - 1);
    const bf16_t* zb = z + (size_t)b * SEQ * INC;
    __syncthreads();
#pragma unroll
    for (int i = 0; i < 8; ++i) {
        const int id = i * 512 + tid, row = id >> 4, cc = id & 15, s = 128 * (n - 1) + row;
        u32x4 v = (u32x4){0u, 0u, 0u, 0u};
        if (s >= 0) v = *(const u32x4*)(zb + (size_t)(s * d + res) * INC + 5120 + hh * 128 + cc * 8);
        *(LAS u32x4*)(lds + row * KROW + cc * 16) = v;
    }
#pragma unroll
    for (int i = 0; i < 8; ++i) {
        const int id = i * 512 + tid, key = id & 255, dc = id >> 8, s = 128 * (n - 1) + key;
        u32x4 v = (u32x4){0u, 0u, 0u, 0u};
        if (s >= 0) v = *(const u32x4*)(zb + (size_t)(s * d + res) * INC + 6144 + hh * 128 + dc * 8);
        LAS bf16_t* vp = (LAS bf16_t*)(lds + VT_OFF + (dc * 8) * VROW + key * 2);
        vp[0 * (VROW / 2)] = (bf16_t)(v.x & 0xffffu); vp[1 * (VROW / 2)] = (bf16_t)(v.x >> 16);
        vp[2 * (VROW / 2)] = (bf16_t)(v.y & 0xffffu); vp[3 * (VROW / 2)] = (bf16_t)(v.y >> 16);
        vp[4 * (VROW / 2)] = (bf16_t)(v.z & 0xffffu); vp[5 * (VROW / 2)] = (bf16_t)(v.z >> 16);
        vp[6 * (VROW / 2)] = (bf16_t)(v.w & 0xffffu); vp[7 * (VROW / 2)] = (bf16_t)(v.w >> 16);
    }
    const int qi = 16 * w + r16;
    const int tokq = b * SEQ + (128 * n + qi) * d + res;
    bf16x8 qf[4];
#pragma unroll
    for (int ks = 0; ks < 4; ++ks) qf[ks] = *(const bf16x8*)(z + (size_t)tokq * INC + 4096 + hh * 128 + 32 * ks + 8 * qq);
    __syncthreads();
    const int w0 = w < 6 ? w : 6;
    f32x4 s[10];
#pragma unroll
    for (int t = 0; t < 10; ++t) {
        s[t] = (f32x4){0.f, 0.f, 0.f, 0.f};
#pragma unroll
        for (int ks = 0; ks < 4; ++ks) {
            const bf16x8 a = *(const LAS bf16x8*)(lds + (16 * (w0 + t) + r16) * KROW + (32 * ks + 8 * qq) * 2);
            s[t] = __builtin_amdgcn_mfma_f32_16x16x32_bf16(a, qf[ks], s[t], 0, 0, 0);
        }
    }
    float mx = -3.0e38f;
#pragma unroll
    for (int t = 0; t < 10; ++t)
#pragma unroll
        for (int j = 0; j < 4; ++j) {
            const int kj = 16 * (w0 + t) + 4 * qq + j;
            const bool valid = (kj >= qi) && (kj <= qi + 128) && (n > 0 || kj >= 128);
            if (valid) mx = fmaxf(mx, s[t][j]);
        }
    mx = fmaxf(mx, __shfl_xor(mx, 16)); mx = fmaxf(mx, __shfl_xor(mx, 32));
    float l = 0.f;
#pragma unroll
    for (int t = 0; t < 10; ++t)
#pragma unroll
        for (int j = 0; j < 4; ++j) {
            const int kj = 16 * (w0 + t) + 4 * qq + j;
            const bool valid = (kj >= qi) && (kj <= qi + 128) && (n > 0 || kj >= 128);
            const float p = valid ? __expf(s[t][j] - mx) : 0.f;
            l += p; s[t][j] = p;
        }
    l += __shfl_xor(l, 16); l += __shfl_xor(l, 32);
    f32x4 o[8];
#pragma unroll
    for (int nd = 0; nd < 8; ++nd) o[nd] = (f32x4){0.f, 0.f, 0.f, 0.f};
#pragma unroll
    for (int i = 0; i < 5; ++i) {
        u32x4 pw; pw.x = cvt_pk_bf16(s[2 * i][0], s[2 * i][1]); pw.y = cvt_pk_bf16(s[2 * i][2], s[2 * i][3]); pw.z = cvt_pk_bf16(s[2 * i + 1][0], s[2 * i + 1][1]); pw.w = cvt_pk_bf16(s[2 * i + 1][2], s[2 * i + 1][3]);
        const bf16x8 pb = __builtin_bit_cast(bf16x8, pw);
#pragma unroll
        for (int nd = 0; nd < 8; ++nd) {
            const LAS unsigned char* ap = lds + VT_OFF + (16 * nd + r16) * VROW + (16 * (w0 + 2 * i) + 4 * qq) * 2;
            const u32x2 a0 = *(const LAS u32x2*)ap, a1 = *(const LAS u32x2*)(ap + 32);
            u32x4 aw; aw.x = a0.x; aw.y = a0.y; aw.z = a1.x; aw.w = a1.y;
            o[nd] = __builtin_amdgcn_mfma_f32_16x16x32_bf16(__builtin_bit_cast(bf16x8, aw), pb, o[nd], 0, 0, 0);
        }
    }
    const float inv = 1.0f / l;
    bf16_t* dst = (g == 0) ? (mixb + (size_t)tokq * DM + 1024 + hh * 128) : ((g == 1 ? part1 : part2) + (size_t)tokq * 1024 + hh * 128);
#pragma unroll
    for (int nd = 0; nd < 8; ++nd) {
        u32x2 ow; ow.x = cvt_pk_bf16(o[nd][0] * inv, o[nd][1] * inv); ow.y = cvt_pk_bf16(o[nd][2] * inv, o[nd][3] * inv);
        *(u32x2*)(dst + 16 * nd + 4 * qq) = ow;
    }
    if (qq == 0) ml[(size_t)g * NTOK * 8 + (size_t)tokq * 8 + hh] = (f32x2){mx, l};
}

__device__ void mixfin_phase(const Params& P, int layer, const bf16_t* z, bf16_t* mixb, const bf16_t* part1, const bf16_t* part2, const f32x2* ml) {
    int tid = threadIdx.x; asm volatile("" : "+v"(tid));
    const int lane = tid & 63, w = tid >> 6;
    const float gh0 = P.hgrn_norm[layer * 128 + 2 * lane], gh1 = P.hgrn_norm[layer * 128 + 2 * lane + 1];
    const float ga0 = P.attn_norm[layer * 128 + 2 * lane], ga1 = P.attn_norm[layer * 128 + 2 * lane + 1];
    for (int tok = blockIdx.x * 8 + w; tok < NTOK; tok += gridDim.x * 8) {
#pragma unroll 2
        for (int hd = 0; hd < 8; ++hd) {
            unsigned* mp = (unsigned*)(mixb + (size_t)tok * DM + hd * 128 + 2 * lane);
            const unsigned u = *mp, zg = *(const unsigned*)(z + (size_t)tok * INC + 3072 + hd * 128 + 2 * lane);
            const float a0 = bf_lo(u), a1 = bf_hi(u);
            const float sq = wave_sum(a0 * a0 + a1 * a1);
            const float rs = rsqrtf(sq * (1.0f / 128.0f) + EPS);
            *mp = cvt_pk_bf16(a0 * rs * gh0 * bf_lo(zg), a1 * rs * gh1 * bf_hi(zg));
        }
#pragma unroll 2
        for (int hd = 0; hd < 8; ++hd) {
            unsigned* mp = (unsigned*)(mixb + (size_t)tok * DM + 1024 + hd * 128 + 2 * lane);
            const unsigned u0 = *mp, u1 = *(const unsigned*)(part1 + (size_t)tok * 1024 + hd * 128 + 2 * lane), u2 = *(const unsigned*)(part2 + (size_t)tok * 1024 + hd * 128 + 2 * lane);
            const f32x2 m0 = ml[(size_t)tok * 8 + hd], m1 = ml[(size_t)NTOK * 8 + (size_t)tok * 8 + hd], m2 = ml[(size_t)2 * NTOK * 8 + (size_t)tok * 8 + hd];
            const float mm = fmaxf(m0.x, fmaxf(m1.x, m2.x));
            const float w0 = m0.y * __expf(m0.x - mm), w1 = m1.y * __expf(m1.x - mm), w2 = m2.y * __expf(m2.x - mm);
            const float iw = 1.0f / (w0 + w1 + w2);
            const float a0 = (w0 * bf_lo(u0) + w1 * bf_lo(u1) + w2 * bf_lo(u2)) * iw, a1 = (w0 * bf_hi(u0) + w1 * bf_hi(u1) + w2 * bf_hi(u2)) * iw;
            const float sq = wave_sum(a0 * a0 + a1 * a1);
            const float rs = rsqrtf(sq * (1.0f / 128.0f) + EPS);
            *mp = cvt_pk_bf16(a0 * rs * ga0, a1 * rs * ga1);
        }
    }
}

__global__ void __launch_bounds__(512, 2) hymba_fwd(Params P) {
    extern __shared__ __attribute__((aligned(16))) unsigned char shm[];
    LAS unsigned char* lds = (LAS unsigned char*)shm;
    cg::grid_group grid = cg::this_grid();
    unsigned char* ws = P.ws;
    const int G = gridDim.x, bid = blockIdx.x;
    bf16_t* hb0 = (bf16_t*)(ws + OFF_HB0); bf16_t* hb1 = (bf16_t*)(ws + OFF_MIX); bf16_t* mixb = hb1;
    bf16_t* z = (bf16_t*)(ws + OFF_G); bf16_t* act = (bf16_t*)(ws + OFF_ACT); bf16_t* PPb = (bf16_t*)(ws + OFF_PP);
    bf16_t* part1 = (bf16_t*)(ws + OFF_HB0); bf16_t* part2 = part1 + (size_t)NTOK * 1024;
    const float* cosT = (const float*)(ws + OFF_CS); const float* sinT = cosT + (size_t)NTOK * 16;
    f32x2* ml = (f32x2*)(ws + OFF_ML); float* ss = (float*)(ws + OFF_SS);

    prep_phase(P, lds);
    grid.sync();
#pragma unroll 1
    for (int l = 0; l < 2; ++l) {
        const unsigned char* wl = ws + OFF_W + (size_t)l * SZ_WL;
        pg8::StaticOrder S;
        { pg8::Gemm g{hb1, (const bf16_t*)(wl + WO_IN), NTOK, INC, DM}; S.init(NTOK, INC, G, bid);
          EpiIn E{z, ss + (size_t)(3 * l) * NTOK, cosT, sinT}; pg8::gemm_phase(lds, g, S, E); }
        grid.sync();
        for (int it = bid; it < 256; it += G) hgrn_item(P, lds, it, l, z, mixb);
        for (int it = bid; it < 3 * 2048; it += G) attn_item(lds, it, z, mixb, part1, part2, ml);
        grid.sync();
        mixfin_phase(P, l, z, mixb, part1, part2, ml);
        grid.sync();
        { pg8::Gemm g{mixb, (const bf16_t*)(wl + WO_OUT), NTOK, DM, DM}; S.init(NTOK, DM, G, bid);
          EpiRes E{l == 0 ? P.x : (const float*)P.out, P.out, hb0, ss + (size_t)(3 * l + 1) * NTOK, 0}; pg8::gemm_phase(lds, g, S, E); }
        { pg8::Gemm g{(const bf16_t*)(ws + OFF_PB) + (size_t)l * NTOK * PLE, (const bf16_t*)(wl + WO_PP), NTOK, DM, PLE}; S.init(NTOK, DM, G, bid);
          EpiPP E{PPb}; pg8::gemm_phase(lds, g, S, E); }
        grid.sync();
#pragma unroll 1
        for (int hf = 0; hf < 2; ++hf) {
            { pg8::Gemm g{hb0 + (size_t)hf * 16384 * DM, (const bf16_t*)(wl + WO_1), 16384, DFF, DM}; S.init(16384, DFF, G, bid);
              EpiAct E{act, ss + (size_t)(3 * l + 1) * NTOK, hf * 16384}; pg8::gemm_phase(lds, g, S, E); }
            grid.sync();
            { pg8::Gemm g{act, (const bf16_t*)(wl + WO_2), 16384, DM, DFF}; S.init(16384, DM, G, bid);
              EpiRes E{(const float*)P.out, P.out, hb0, ss + (size_t)(3 * l + 2) * NTOK, hf * 16384}; pg8::gemm_phase(lds, g, S, E); }
            grid.sync();
        }
        { pg8::Gemm g{hb0, (const bf16_t*)(wl + WO_PG), NTOK, DM, DM}; S.init(NTOK, DM, G, bid);
          EpiPle E{P.out, hb1, PPb, ss + (size_t)(3 * l + 2) * NTOK, ss + (size_t)(3 * l + 3) * NTOK}; pg8::gemm_phase(lds, g, S, E); }
        grid.sync();
    }
    {
        const int tid = threadIdx.x, lane = tid & 63, w = tid >> 6;
        const float* ssf = ss + (size_t)6 * NTOK;
        for (int row = bid * 8 + w; row < NTOK; row += G * 8) {
            const float rs = rsqrtf(ssf[row] * (1.0f / DM) + EPS);
            float* hr = P.out + (size_t)row * DM;
#pragma unroll
            for (int i = 0; i < 8; ++i) {
                f32x4 v = *(const f32x4*)(hr + i * 256 + lane * 4); const f32x4 gn = *(const f32x4*)(P.final_norm + i * 256 + lane * 4);
                v = v * rs * gn; *(f32x4*)(hr + i * 256 + lane * 4) = v;
            }
        }
    }
}

extern "C" void kernel_launch(void* const* d_in, const int* in_sizes, int n_in, void* d_out, int out_size, void* d_ws, size_t ws_size, hipStream_t stream) {
    static int grid_blocks = 0;
    if (grid_blocks == 0) {
        if (n_in != 16 || ws_size < WS_END || out_size != NTOK * DM) { fprintf(stderr, "kernel_launch: unexpected problem (n_in %d, ws %zu need %zu, out %d)\n", n_in, ws_size, (size_t)WS_END, out_size); grid_blocks = -1; return; }
        int dev = 0, cus = 0, per_cu = 0;
        hipGetDevice(&dev);
        hipDeviceGetAttribute(&cus, hipDeviceAttributeMultiprocessorCount, dev);
        if (hipFuncSetAttribute((const void*)hymba_fwd, hipFuncAttributeMaxDynamicSharedMemorySize, LDS_BYTES) != hipSuccess) { fprintf(stderr, "kernel_launch: hipFuncSetAttribute failed\n"); grid_blocks = -1; return; }
        if (hipOccupancyMaxActiveBlocksPerMultiprocessor(&per_cu, (const void*)hymba_fwd, 512, LDS_BYTES) != hipSuccess || per_cu < 1) { fprintf(stderr, "kernel_launch: occupancy query gave %d\n", per_cu); per_cu = 1; }
        (void)hipGetLastError();
        grid_blocks = cus;
    }
    if (grid_blocks < 0) return;
    Params P{};
    P.x = (const float*)d_in[0]; P.p = (const float*)d_in[1]; P.pos = (const int*)d_in[2];
    P.norm1 = (const float*)d_in[3]; P.w_in = (const float*)d_in[4]; P.lb = (const float*)d_in[5]; P.hgrn_norm = (const float*)d_in[6]; P.attn_norm = (const float*)d_in[7];
    P.w_out = (const float*)d_in[8]; P.norm2 = (const float*)d_in[9]; P.w1 = (const float*)d_in[10]; P.w2 = (const float*)d_in[11]; P.ple_norm = (const float*)d_in[12];
    P.w_pg = (const float*)d_in[13]; P.w_pp = (const float*)d_in[14]; P.final_norm = (const float*)d_in[15];
    P.out = (float*)d_out; P.ws = (unsigned char*)d_ws;
    void* args[] = {&P};
    hipError_t e = hipLaunchCooperativeKernel((const void*)hymba_fwd, dim3(grid_blocks), dim3(512), args, LDS_BYTES, stream);
    if (e != hipSuccess) fprintf(stderr, "cooperative launch failed: %s (grid %d)\n", hipGetErrorString(e), grid_blocks);
}
```

```cpp
#include <hip/hip_runtime.h>
#include <hip/hip_cooperative_groups.h>
#include <cstdio>
namespace cg = cooperative_groups;

#define LAS __attribute__((address_space(3)))
typedef unsigned short bf16_t;
typedef short bf16x8 __attribute__((ext_vector_type(8)));
typedef float f32x4 __attribute__((ext_vector_type(4)));
typedef float f32x2 __attribute__((ext_vector_type(2)));
typedef unsigned u32x4 __attribute__((ext_vector_type(4)));
typedef unsigned u32x2 __attribute__((ext_vector_type(2)));

constexpr int NTOK = 32768, DM = 2048, INC = 7168, DFF = 8192, PLE = 256, SEQ = 8192;
constexpr float EPS = 1e-6f;
constexpr int LDS_BYTES = 143360 + 32;

constexpr size_t SZ_WIN = (size_t)INC * DM * 2, SZ_WOUT = (size_t)DM * DM * 2, SZ_W1 = (size_t)DFF * DM * 2, SZ_W2 = SZ_W1, SZ_WPG = SZ_WOUT, SZ_WPP = (size_t)DM * PLE * 2;
constexpr size_t WO_IN = 0, WO_OUT = WO_IN + SZ_WIN, WO_1 = WO_OUT + SZ_WOUT, WO_2 = WO_1 + SZ_W1, WO_PG = WO_2 + SZ_W2, WO_PP = WO_PG + SZ_WPG, SZ_WL = WO_PP + SZ_WPP;
constexpr size_t OFF_W = 0;
constexpr size_t OFF_HB0 = OFF_W + 2 * SZ_WL;
constexpr size_t SZ_HB = (size_t)NTOK * DM * 2;
constexpr size_t OFF_G = OFF_HB0 + SZ_HB;
constexpr size_t SZ_Z = (size_t)NTOK * INC * 2;
constexpr size_t OFF_MIX = OFF_G + SZ_Z;
constexpr size_t OFF_ACT = OFF_G;
constexpr size_t OFF_PP = OFF_G + (size_t)16384 * DFF * 2;
constexpr size_t OFF_PB = OFF_MIX + SZ_HB;
constexpr size_t SZ_PB = 2ull * NTOK * PLE * 2;
constexpr size_t OFF_CS = OFF_PB + SZ_PB;
constexpr size_t SZ_CS = 2ull * NTOK * 16 * 4;
constexpr size_t OFF_ML = OFF_CS + SZ_CS;
constexpr size_t SZ_ML = 3ull * NTOK * 8 * 8;
constexpr size_t OFF_SS = OFF_ML + SZ_ML;
constexpr size_t SZ_SS = 7ull * NTOK * 4;
constexpr size_t WS_END = OFF_SS + SZ_SS;
static_assert(OFF_PP + SZ_HB <= OFF_MIX, "PP overlaps mix");


#ifndef PROBE_MASK1
#define PROBE_MASK1 0u
#endif
#ifndef PROBE_MASK2
#define PROBE_MASK2 0u
#endif
#ifndef PROBE_A
#define PROBE_A 0
#endif
#ifndef PROBE_B
#define PROBE_B 0
#endif
#ifndef PROBE_CLK
#define PROBE_CLK 0
#endif
#ifndef PROBE_SYNC
#define PROBE_SYNC 0
#endif
#ifndef PROBE_K
#define PROBE_K 0.013f
#endif
#define PROBE_ON ((PROBE_B) != 0 || (PROBE_MASK1) != 0u)
constexpr size_t OFF_TS = WS_END;
constexpr size_t OFF_D = WS_END + 4096;
constexpr size_t OFF_U = OFF_D + 32ull * 8 * 128 * 4;
constexpr size_t WS_NEED = OFF_U + 32ull * 8 * 16384 * 4;
constexpr size_t OFF_SSP = WS_NEED;
constexpr size_t WS_NEED2 = OFF_SSP + 7ull * NTOK * 32 * 4;
constexpr size_t OFF_BAR = WS_NEED2;
constexpr size_t WS_NEED3 = OFF_BAR + 16384;
constexpr size_t OFF_CTR = WS_END + 256;
__device__ __forceinline__ void stamp(unsigned char* ws, int i) {
#if PROBE_ON
    if (blockIdx.x == 0 && threadIdx.x == 0) { ((unsigned long long*)(ws + OFF_TS))[i] = __builtin_amdgcn_s_memrealtime(); ((unsigned long long*)(ws + OFF_TS))[64 + i] = __builtin_amdgcn_s_memtime(); }
#endif
}

struct Params {
    const float* x; const float* p; const int* pos;
    const float* norm1; const float* w_in; const float* lb; const float* hgrn_norm; const float* attn_norm; const float* w_out;
    const float* norm2; const float* w1; const float* w2; const float* ple_norm; const float* w_pg; const float* w_pp; const float* final_norm;
    float* out; unsigned char* ws;
};

__device__ __forceinline__ unsigned cvt_pk_bf16(float lo, float hi) { unsigned r; asm volatile("v_cvt_pk_bf16_f32 %0, %1, %2" : "=v"(r) : "v"(lo), "v"(hi)); return r; }
__device__ __forceinline__ float bf_lo(unsigned u) { return __uint_as_float(u << 16); }
__device__ __forceinline__ float bf_hi(unsigned u) { return __uint_as_float(u & 0xffff0000u); }
__device__ __forceinline__ float bf2f(bf16_t b) { return __uint_as_float(((unsigned)b) << 16); }
__device__ __forceinline__ bf16_t f2bf(float f) { return (bf16_t)(cvt_pk_bf16(f, 0.f) & 0xffffu); }
__device__ __forceinline__ float sigmoidf_(float v) { return __builtin_amdgcn_rcpf(1.0f + __expf(-v)); }
__device__ __forceinline__ float siluf_(float v) { return v * __builtin_amdgcn_rcpf(1.0f + __expf(-v)); }
__device__ __forceinline__ float wave_sum(float v) {
    v += __shfl_xor(v, 32); v += __shfl_xor(v, 16); v += __shfl_xor(v, 8); v += __shfl_xor(v, 4); v += __shfl_xor(v, 2); v += __shfl_xor(v, 1); return v;
}
__device__ __forceinline__ void atomic_addf(float* p, float v) { __hip_atomic_fetch_add(p, v, __ATOMIC_RELAXED, __HIP_MEMORY_SCOPE_AGENT); }


#define XB_TMO      128
#define XB_XCNT(j)  (256  + 64 * (j))
#define XB_XSUB(j)  (1280 + 64 * (j))
#define XB_XGEN(j)  (2304 + 64 * (j))
#define XB_TOP      3328
#define XB_TOPGEN   3392
#define XCD_BAR_WORDS 3456
#define XB_SPIN_CAP (1u << 18)

__device__ __forceinline__ unsigned xb_ld(unsigned* p)              { return __hip_atomic_load(p, __ATOMIC_RELAXED, __HIP_MEMORY_SCOPE_AGENT); }
__device__ __forceinline__ unsigned xb_add(unsigned* p, unsigned v) { return __hip_atomic_fetch_add(p, v, __ATOMIC_RELAXED, __HIP_MEMORY_SCOPE_AGENT); }
__device__ __forceinline__ unsigned xb_xcc_id() { return (unsigned)__builtin_amdgcn_s_getreg((3 << 11) | 20) & 0xFu; }
#define XB_SPIN(cond, bar) do { unsigned _sp = 0; while (cond) { __builtin_amdgcn_s_sleep(1); \
    if ((++_sp & 255u) == 0u) { if (xb_ld(&(bar)[XB_TMO])) break; if (_sp > XB_SPIN_CAP) { atomicAdd(&(bar)[XB_TMO], 1u); break; } } } } while (0)

struct XcdBarrier {
    unsigned* bar; unsigned x;
    volatile LAS unsigned* st;
};

__device__ __forceinline__ XcdBarrier xcd_barrier_post(unsigned* bar, volatile LAS unsigned* st) {
    XcdBarrier b; b.bar = bar; b.x = xb_xcc_id(); b.st = st;
    if (threadIdx.x == 0) (void)xb_add(&bar[XB_XCNT(b.x)], 1u);
    return b;
}
__device__ __forceinline__ void xcd_barrier_complete(unsigned* bar, unsigned x, unsigned& nloc, unsigned& nx) {
    const unsigned G = gridDim.x * gridDim.y * gridDim.z;
    unsigned sum, cnt, mine, sp = 0u;
    for (;;) {
        sum = 0u; cnt = 0u; mine = 0u;
#pragma unroll
        for (unsigned j = 0; j < 16; ++j) { const unsigned c = xb_ld(&bar[XB_XCNT(j)]); sum += c; cnt += (c > 0u) ? 1u : 0u; mine = (j == x) ? c : mine; }
        if (sum == G) break;
        __builtin_amdgcn_s_sleep(1);
        if ((++sp & 255u) == 0u) { if (xb_ld(&bar[XB_TMO])) break; if (sp > XB_SPIN_CAP) { atomicAdd(&bar[XB_TMO], 1u); break; } }
    }
    nloc = mine > 0u ? mine : 1u; nx = cnt > 0u ? cnt : 1u;
}

__device__ __forceinline__ void xcd_barrier(const XcdBarrier& b) {
    asm volatile("s_waitcnt vmcnt(0)" ::: "memory");
    __syncthreads();
    if (threadIdx.x == 0) {
        unsigned* bar = b.bar;
        __builtin_amdgcn_s_waitcnt(0);
        unsigned nloc = b.st[0], nx = b.st[1];
        if (nloc == 0u) { xcd_barrier_complete(bar, b.x, nloc, nx); b.st[0] = nloc; b.st[1] = nx; }
        const unsigned old = xb_add(&bar[XB_XSUB(b.x)], 1u);
        const unsigned gen = old / nloc;
        if (old + 1u == (gen + 1u) * nloc) {
            __builtin_amdgcn_fence(__ATOMIC_RELEASE, "agent");
            asm volatile("s_waitcnt vmcnt(0)" ::: "memory");
            const unsigned og = xb_add(&bar[XB_TOP], 1u);
            const unsigned tg = og / nx;
            if (og + 1u == (tg + 1u) * nx) xb_add(&bar[XB_TOPGEN], 1u);
            else XB_SPIN(xb_ld(&bar[XB_TOPGEN]) == tg, bar);
            __builtin_amdgcn_fence(__ATOMIC_ACQUIRE, "agent");
            xb_add(&bar[XB_XGEN(b.x)], 1u);
            asm volatile("s_waitcnt vmcnt(0)" ::: "memory");
        } else {
            XB_SPIN(xb_ld(&bar[XB_XGEN(b.x)]) == gen, bar);
            __builtin_amdgcn_fence(__ATOMIC_ACQUIRE, "agent");
            asm volatile("s_waitcnt vmcnt(0)" ::: "memory");
        }
    }
    __syncthreads();
}


#ifndef ORDER_T
#define ORDER_T 0
#endif
namespace pg8 {
constexpr int BM = 256, BK = 64, HALF = 128, HTB = HALF * BK * 2, STAGE_BYTES = 8 * HTB, NXCD = 8, WGM = 4;
__host__ __device__ __forceinline__ int lds_byte(int r, int c) { const int st = (r >> 4) * 2 + (c >> 5), rr = r & 15, cc = c & 31, ob = rr * 64 + cc * 2; return st * 1024 + (ob ^ (((ob >> 9) & 1) << 5)); }
__host__ __device__ __forceinline__ void stage_rc(int b, int& R, int& C) { const int st = b / 1024, sb = b % 1024, swz = sb ^ (((sb >> 9) & 1) << 5); R = (st >> 1) * 16 + swz / 64; C = (st & 1) * 32 + (swz % 64) / 2; }
__host__ __device__ __forceinline__ int perm32(int rho) { const int n = rho >> 4, i = rho & 15; return 8 * (i >> 2) + 4 * n + (i & 3); }
struct Unit { int pm, pn; };
struct Gemm { const bf16_t* A; const bf16_t* Bt; int M, N, K; };
struct StaticOrder {
    int nM, nN, nwg, G, c;
    __device__ void init(int M, int N, int G_, int c_) { nM = M / BM; nN = N / BM; nwg = nM * nN; G = G_; asm volatile("" : "+s"(c_)); c = c_; }
    __device__ bool next(int i, Unit& u) const {
        const long L = (long)i * G + c; if (L >= nwg) return false;
        int wgid = (int)L; { const int q = nwg / NXCD, r = nwg % NXCD, xcd = wgid % NXCD, off = wgid / NXCD; wgid = (xcd < r ? xcd * (q + 1) : r * (q + 1) + (xcd - r) * q) + off; }
#if ORDER_T
        const int nig = WGM * nM, gid = wgid / nig, fn = gid * WGM, gsz = (nN - fn) < WGM ? (nN - fn) : WGM;
        u.pn = fn + ((wgid % nig) % gsz); u.pm = (wgid % nig) / gsz; return true;
#else
        const int nig = WGM * nN, gid = wgid / nig, fm = gid * WGM, gsz = (nM - fm) < WGM ? (nM - fm) : WGM;
        u.pm = fm + ((wgid % nig) % gsz); u.pn = (wgid % nig) / gsz; return true;
#endif
    }
};

template <class Epi>
__device__ __forceinline__ void gemm_phase(LAS unsigned char* lds, const Gemm g, const StaticOrder& S, const Epi& E) {
    int tid = threadIdx.x; asm volatile("" : "+v"(tid));
    const int wid = __builtin_amdgcn_readfirstlane(tid >> 6), lane = tid & 63, wr = wid >> 2, wc = wid & 3, fr = lane & 15, fq = lane >> 4;
    const int K = g.K, nt = K / BK;
    unsigned voffA[2], voffB[2];
#pragma unroll
    for (int i = 0; i < 2; ++i) { int R, C; stage_rc(tid * 16 + i * 8192, R, C); const int Rb = (R & ~31) + perm32(R & 31);
        voffA[i] = (unsigned)(R * K + C) * 2u; voffB[i] = (unsigned)(Rb * K + C) * 2u; }
    const size_t kstep = (size_t)(BK * 2);
    const size_t hstep = (size_t)HALF * K * 2;
    const size_t tstep = 2 * hstep;
    const unsigned ldsw = (unsigned)wid * 1024u;
    const int aoff = lds_byte(wr * 64 + fr, fq * 8), boff = lds_byte(wc * 32 + fr, fq * 8);
#define PG8_SA(b, h) (((b) * 2 + (h)) * HTB)
#define PG8_SB(b, h) ((4 + (b) * 2 + (h)) * HTB)
#define PG8_STAGE(bufoff, gbase, voff) do { _Pragma("unroll") for (int _i = 0; _i < 2; ++_i) \
        __builtin_amdgcn_global_load_lds((const unsigned*)((const char*)(gbase) + (voff)[_i]), (LAS unsigned*)(lds + (bufoff) + ldsw + _i * 8192), 16, 0, 0); } while (0)
#define PG8_LDA(dst, b, h) do { _Pragma("unroll") for (int m = 0; m < 4; ++m) _Pragma("unroll") for (int k = 0; k < 2; ++k) dst[m][k] = *(const LAS bf16x8*)(lds + PG8_SA(b, h) + aoff + m * 2048 + k * 1024); } while (0)
#define PG8_LDB(dst, b, h) do { _Pragma("unroll") for (int n = 0; n < 2; ++n) _Pragma("unroll") for (int k = 0; k < 2; ++k) dst[n][k] = *(const LAS bf16x8*)(lds + PG8_SB(b, h) + boff + n * 2048 + k * 1024); } while (0)
#define PG8_MMA(ai, bj, At, Bt) do { __builtin_amdgcn_s_setprio(1); _Pragma("unroll") for (int m = 0; m < 4; ++m) _Pragma("unroll") for (int n = 0; n < 2; ++n) _Pragma("unroll") for (int k = 0; k < 2; ++k) \
        acc[ai][bj][m][n] = __builtin_amdgcn_mfma_f32_16x16x32_bf16(Bt[n][k], At[m][k], acc[ai][bj][m][n], 0, 0, 0); __builtin_amdgcn_s_setprio(0); } while (0)
#define PG8_WAIT_V(n) asm volatile("s_waitcnt vmcnt(" #n ")" ::: "memory")
#define PG8_WAIT_L(n) asm volatile("s_waitcnt lgkmcnt(" #n ")" ::: "memory")
#define PG8_BAR __builtin_amdgcn_s_barrier()
#define PG8_SCHED __builtin_amdgcn_sched_barrier(0)
    Unit cur, nxt; int ui = 0;
    if (!S.next(0, cur)) return;
    f32x4 acc[2][2][4][2];
#pragma unroll
    for (int a = 0; a < 2; ++a)
#pragma unroll
        for (int b = 0; b < 2; ++b)
#pragma unroll
            for (int m = 0; m < 4; ++m)
#pragma unroll
                for (int n = 0; n < 2; ++n) acc[a][b][m][n] = (f32x4){0.f, 0.f, 0.f, 0.f};
    bf16x8 At[4][2], B0[2][2], B1[2][2];
    const char* cA = (const char*)g.A + (size_t)cur.pm * tstep; const char* cB = (const char*)g.Bt + (size_t)cur.pn * tstep;
    PG8_STAGE(PG8_SB(0, 0), cB, voffB); PG8_STAGE(PG8_SA(0, 0), cA, voffA); PG8_STAGE(PG8_SB(0, 1), cB + hstep, voffB); PG8_STAGE(PG8_SA(0, 1), cA + hstep, voffA);
    if (wr == 1) PG8_BAR;
    PG8_WAIT_V(4); PG8_BAR;
    PG8_STAGE(PG8_SB(1, 0), cB + kstep, voffB); PG8_STAGE(PG8_SA(1, 0), cA + kstep, voffA); PG8_STAGE(PG8_SB(1, 1), cB + hstep + kstep, voffB);
    PG8_WAIT_V(6); PG8_BAR;
    for (;;) {
        const bool has_next = S.next(ui + 1, nxt);
        const char* nA = has_next ? (const char*)g.A + (size_t)nxt.pm * tstep : cA; const char* nB = has_next ? (const char*)g.Bt + (size_t)nxt.pn * tstep : cB;
        for (int t = 0; t < nt; t += 2) {
            const bool last = (t == nt - 2);
            const char* a1 = cA + (size_t)(t + 1) * kstep;
            const char* a2 = last ? nA : cA + (size_t)(t + 2) * kstep; const char* b2 = last ? nB : cB + (size_t)(t + 2) * kstep;
            const char* a3 = a2 + kstep; const char* b3 = b2 + kstep;
            PG8_LDB(B0, 0, 0); PG8_SCHED; PG8_LDA(At, 0, 0); PG8_STAGE(PG8_SA(1, 1), a1 + hstep, voffA);
            PG8_WAIT_L(8); PG8_BAR; PG8_WAIT_L(0); PG8_MMA(0, 0, At, B0); PG8_BAR; PG8_SCHED;
            PG8_LDB(B1, 0, 1); PG8_STAGE(PG8_SB(0, 0), b2, voffB);
            PG8_BAR; PG8_WAIT_L(0); PG8_MMA(0, 1, At, B1); PG8_BAR;
            PG8_LDA(At, 0, 1); PG8_STAGE(PG8_SA(0, 0), a2, voffA);
            PG8_BAR; PG8_WAIT_L(0); PG8_MMA(1, 0, At, B0); PG8_BAR; PG8_SCHED;
            PG8_STAGE(PG8_SB(0, 1), b2 + hstep, voffB);
            PG8_WAIT_V(6); PG8_BAR; PG8_MMA(1, 1, At, B1); PG8_BAR;
            PG8_LDB(B0, 1, 0); PG8_SCHED; PG8_LDA(At, 1, 0); PG8_STAGE(PG8_SA(0, 1), a2 + hstep, voffA);
            PG8_WAIT_L(8); PG8_BAR; PG8_WAIT_L(0); PG8_MMA(0, 0, At, B0); PG8_BAR; PG8_SCHED;
            PG8_LDB(B1, 1, 1); PG8_STAGE(PG8_SB(1, 0), b3, voffB);
            PG8_BAR; PG8_WAIT_L(0); PG8_MMA(0, 1, At, B1); PG8_BAR;
            PG8_LDA(At, 1, 1); PG8_STAGE(PG8_SA(1, 0), a3, voffA);
            PG8_BAR; PG8_WAIT_L(0); PG8_MMA(1, 0, At, B0); PG8_BAR; PG8_SCHED;
            PG8_STAGE(PG8_SB(1, 1), b3 + hstep, voffB);
            PG8_WAIT_V(6); PG8_BAR; PG8_MMA(1, 1, At, B1); PG8_BAR;
        }
        E(acc, cur, wr, wc, fr, fq);
        if (!has_next) break;
#pragma unroll
        for (int a = 0; a < 2; ++a)
#pragma unroll
            for (int b = 0; b < 2; ++b)
#pragma unroll
                for (int m = 0; m < 4; ++m)
#pragma unroll
                    for (int n = 0; n < 2; ++n) acc[a][b][m][n] = (f32x4){0.f, 0.f, 0.f, 0.f};
        cur = nxt; cA = nA; cB = nB; ++ui;
    }
    PG8_WAIT_V(0);
    if (wr == 0) PG8_BAR;
    PG8_BAR;
#undef PG8_SA
#undef PG8_SB
#undef PG8_STAGE
#undef PG8_LDA
#undef PG8_LDB
#undef PG8_MMA
#undef PG8_WAIT_V
#undef PG8_WAIT_L
#undef PG8_BAR
#undef PG8_SCHED
}
}
using pg8::Unit;

#define EPI_HEAD \
        int ln_ = threadIdx.x & 63; asm volatile("" : "+v"(ln_)); const int fr = ln_ & 15, fq = ln_ >> 4; (void)fr_in; (void)fq_in;     \
        const int col0 = u.pn * 256 + wc * 32 + 8 * fq;
#define SB __builtin_amdgcn_sched_barrier(0)
struct SsLoad { f32x4 a, b; };
__device__ __forceinline__ SsLoad ss_load(const float* ssp, int row, int fq) { SsLoad r; const float* p = ssp + (size_t)row * 32 + 8 * fq; r.a = *(const f32x4*)p; r.b = *(const f32x4*)(p + 4); return r; }
__device__ __forceinline__ float ss_sum(const SsLoad& r) { float s = ((r.a[0] + r.a[1]) + (r.a[2] + r.a[3])) + ((r.b[0] + r.b[1]) + (r.b[2] + r.b[3])); s += __shfl_xor(s, 16); s += __shfl_xor(s, 32); return s; }
__device__ __forceinline__ u32x4 pack8(const f32x4& v0, const f32x4& v1) { u32x4 w; w.x = cvt_pk_bf16(v0[0], v0[1]); w.y = cvt_pk_bf16(v0[2], v0[3]); w.z = cvt_pk_bf16(v1[0], v1[1]); w.w = cvt_pk_bf16(v1[2], v1[3]); return w; }
__device__ __forceinline__ float sumsq8(const f32x4& a, const f32x4& b) { return a[0] * a[0] + a[1] * a[1] + a[2] * a[2] + a[3] * a[3] + b[0] * b[0] + b[1] * b[1] + b[2] * b[2] + b[3] * b[3]; }

struct EpiIn {
    bf16_t* Z; const float* ss; const float* cosT; const float* sinT;
    __device__ __forceinline__ void operator()(const f32x4 (&acc)[2][2][4][2], const Unit& u, int wr, int wc, int fr_in, int fq_in) const {
        EPI_HEAD
        const int row0 = u.pm * 256 + wr * 64 + fr;
        const int typ = u.pn >> 2;
        const bool rot = (typ == 4 || typ == 5) && (wc == 0);
        const float sgn = (fq < 2) ? -1.0f : 1.0f;
        SB;
        float rs8[2][4];
        {
            SsLoad sl[2][4];
#pragma unroll
            for (int ai = 0; ai < 2; ++ai)
#pragma unroll
                for (int m = 0; m < 4; ++m) sl[ai][m] = ss_load(ss, row0 + ai * 128 + m * 16, fq);
            SB;
#pragma unroll
            for (int ai = 0; ai < 2; ++ai)
#pragma unroll
                for (int m = 0; m < 4; ++m) rs8[ai][m] = ss_sum(sl[ai][m]);
        }
#pragma unroll
        for (int ai = 0; ai < 2; ++ai)
#pragma unroll
        for (int mh = 0; mh < 2; ++mh) {
            SB;
            float rs[2]; f32x4 c0[2], c1[2], s0[2], s1[2];
#pragma unroll
            for (int mm = 0; mm < 2; ++mm) {
                const int row = row0 + ai * 128 + (2 * mh + mm) * 16;
                rs[mm] = rs8[ai][2 * mh + mm];
                c0[mm] = (f32x4){1.f, 1.f, 1.f, 1.f}; c1[mm] = c0[mm]; s0[mm] = (f32x4){0.f, 0.f, 0.f, 0.f}; s1[mm] = s0[mm];
                if (rot) { const float* cp = cosT + (size_t)row * 16 + 8 * (fq & 1); const float* sp = sinT + (size_t)row * 16 + 8 * (fq & 1);
                    c0[mm] = *(const f32x4*)cp; c1[mm] = *(const f32x4*)(cp + 4); s0[mm] = *(const f32x4*)sp; s1[mm] = *(const f32x4*)(sp + 4); }
            }
            SB;
#pragma unroll
            for (int mm = 0; mm < 2; ++mm) {
                const int m = 2 * mh + mm, row = row0 + ai * 128 + m * 16;
                const float r = rsqrtf(rs[mm] * (1.0f / DM) + EPS);
                bf16_t* rowp = Z + (size_t)row * INC + col0;
#pragma unroll
                for (int bj = 0; bj < 2; ++bj) {
                    f32x4 v0 = acc[ai][bj][m][0] * r, v1 = acc[ai][bj][m][1] * r;
                    if (typ == 0 || typ == 3) {
#pragma unroll
                        for (int j = 0; j < 4; ++j) { v0[j] = siluf_(v0[j]); v1[j] = siluf_(v1[j]); }
                    }
                    if (rot) {
                        f32x4 p0, p1;
#pragma unroll
                        for (int j = 0; j < 4; ++j) { p0[j] = __shfl_xor(v0[j], 32); p1[j] = __shfl_xor(v1[j], 32); }
                        v0 = v0 * c0[mm] + (p0 * s0[mm]) * sgn; v1 = v1 * c1[mm] + (p1 * s1[mm]) * sgn;
                    }
                    if (typ == 4) { v0 = v0 * 0.08838834764831845f; v1 = v1 * 0.08838834764831845f; }
                    *(u32x4*)(rowp + bj * 128) = pack8(v0, v1);
                }
            }
        }
    }
};
__device__ __forceinline__ void unpack8(const u32x4& p, f32x4& a, f32x4& b) { a[0] = bf_lo(p.x); a[1] = bf_hi(p.x); a[2] = bf_lo(p.y); a[3] = bf_hi(p.y); b[0] = bf_lo(p.z); b[1] = bf_hi(p.z); b[2] = bf_lo(p.w); b[3] = bf_hi(p.w); }
struct EpiRes {
    const bf16_t* hin; bf16_t* hb; float* ssacc; int row_off;
    __device__ __forceinline__ void operator()(const f32x4 (&acc)[2][2][4][2], const Unit& u, int wr, int wc, int fr_in, int fq_in) const {
        EPI_HEAD
        const int row0 = row_off + u.pm * 256 + wr * 64 + fr;
#pragma unroll
        for (int ai = 0; ai < 2; ++ai) {
            SB;
            u32x4 hv[4][2];
#pragma unroll
            for (int m = 0; m < 4; ++m)
#pragma unroll
                for (int bj = 0; bj < 2; ++bj) hv[m][bj] = *(const u32x4*)(hin + (size_t)(row0 + ai * 128 + m * 16) * DM + col0 + bj * 128);
            SB;
#pragma unroll
            for (int m = 0; m < 4; ++m) {
                const int row = row0 + ai * 128 + m * 16;
                float sq = 0.f;
#pragma unroll
                for (int bj = 0; bj < 2; ++bj) {
                    f32x4 h0, h1; unpack8(hv[m][bj], h0, h1);
                    h0 = h0 + acc[ai][bj][m][0]; h1 = h1 + acc[ai][bj][m][1];
                    sq += sumsq8(h0, h1);
                    *(u32x4*)(hb + (size_t)row * DM + col0 + bj * 128) = pack8(h0, h1);
                }
                sq += __shfl_xor(sq, 16); sq += __shfl_xor(sq, 32);
                if (fq == 0) ssacc[(size_t)row * 32 + u.pn * 4 + wc] = sq;
            }
        }
    }
};
struct EpiAct {
    bf16_t* act; const float* ss; int row_off;
    __device__ __forceinline__ void operator()(const f32x4 (&acc)[2][2][4][2], const Unit& u, int wr, int wc, int fr_in, int fq_in) const {
        EPI_HEAD
        const int row0 = u.pm * 256 + wr * 64 + fr;
        SB;
        float rs[2][4];
        {
            SsLoad sl[2][4];
#pragma unroll
            for (int ai = 0; ai < 2; ++ai)
#pragma unroll
                for (int m = 0; m < 4; ++m) sl[ai][m] = ss_load(ss, row_off + row0 + ai * 128 + m * 16, fq);
            SB;
#pragma unroll
            for (int ai = 0; ai < 2; ++ai)
#pragma unroll
                for (int m = 0; m < 4; ++m) rs[ai][m] = ss_sum(sl[ai][m]);
        }
        SB;
#pragma unroll
        for (int ai = 0; ai < 2; ++ai)
#pragma unroll
            for (int m = 0; m < 4; ++m) {
                const int row = row0 + ai * 128 + m * 16;
                const float r = rsqrtf(rs[ai][m] * (1.0f / DM) + EPS);
#pragma unroll
                for (int bj = 0; bj < 2; ++bj) {
                    f32x4 v0 = acc[ai][bj][m][0] * r, v1 = acc[ai][bj][m][1] * r;
#pragma unroll
                    for (int j = 0; j < 4; ++j) { const float a = fmaxf(v0[j], 0.f), b = fmaxf(v1[j], 0.f); v0[j] = a * a; v1[j] = b * b; }
                    *(u32x4*)(act + (size_t)row * DFF + col0 + bj * 128) = pack8(v0, v1);
                }
            }
    }
};
struct EpiPP {
    bf16_t* O;
    __device__ __forceinline__ void operator()(const f32x4 (&acc)[2][2][4][2], const Unit& u, int wr, int wc, int fr_in, int fq_in) const {
        EPI_HEAD
        const int row0 = u.pm * 256 + wr * 64 + fr;
#pragma unroll
        for (int ai = 0; ai < 2; ++ai)
#pragma unroll
            for (int m = 0; m < 4; ++m) {
                const int row = row0 + ai * 128 + m * 16;
#pragma unroll
                for (int bj = 0; bj < 2; ++bj) *(u32x4*)(O + (size_t)row * DM + col0 + bj * 128) = pack8(acc[ai][bj][m][0], acc[ai][bj][m][1]);
            }
    }
};
struct EpiPle {
    const bf16_t* hin; bf16_t* hb; float* fout; const bf16_t* PP; const float* ss; float* ssacc;
    __device__ __forceinline__ void operator()(const f32x4 (&acc)[2][2][4][2], const Unit& u, int wr, int wc, int fr_in, int fq_in) const {
        EPI_HEAD
        const int row0 = u.pm * 256 + wr * 64 + fr;
#pragma unroll
        for (int ai = 0; ai < 2; ++ai)
#pragma unroll
        for (int mh = 0; mh < 2; ++mh) {
            SB;
            u32x4 hv[2][2], pp[2][2]; float rs[2]; SsLoad sl[2];
#pragma unroll
            for (int mm = 0; mm < 2; ++mm) {
                const int row = row0 + ai * 128 + (2 * mh + mm) * 16;
                sl[mm] = ss_load(ss, row, fq);
#pragma unroll
                for (int bj = 0; bj < 2; ++bj) { const size_t o = (size_t)row * DM + col0 + bj * 128; hv[mm][bj] = *(const u32x4*)(hin + o); pp[mm][bj] = *(const u32x4*)(PP + o); }
            }
            SB;
            rs[0] = ss_sum(sl[0]); rs[1] = ss_sum(sl[1]);
#pragma unroll
            for (int mm = 0; mm < 2; ++mm) {
                const int m = 2 * mh + mm, row = row0 + ai * 128 + m * 16;
                const float r = rsqrtf(rs[mm] * (1.0f / DM) + EPS);
                float sq = 0.f;
#pragma unroll
                for (int bj = 0; bj < 2; ++bj) {
                    const size_t o = (size_t)row * DM + col0 + bj * 128;
                    f32x4 h0, h1, p0, p1; unpack8(hv[mm][bj], h0, h1); unpack8(pp[mm][bj], p0, p1);
                    f32x4 g0 = acc[ai][bj][m][0] * r, g1 = acc[ai][bj][m][1] * r;
#pragma unroll
                    for (int j = 0; j < 4; ++j) { g0[j] = sigmoidf_(g0[j]); g1[j] = sigmoidf_(g1[j]); }
                    h0 = h0 + p0 * g0; h1 = h1 + p1 * g1;
                    sq += sumsq8(h0, h1);
                    if (fout) { *(f32x4*)(fout + o) = h0; *(f32x4*)(fout + o + 4) = h1; }
                    else *(u32x4*)(hb + o) = pack8(h0, h1);
                }
                sq += __shfl_xor(sq, 16); sq += __shfl_xor(sq, 32);
                if (fq == 0) ssacc[(size_t)row * 32 + u.pn * 4 + wc] = sq;
            }
        }
    }
};

__device__ void transpose_job(LAS unsigned char* lds, const float* src, const float* gain, bf16_t* dst, int K, int N) {
    LAS float* tile = (LAS float*)lds;
    int tid = threadIdx.x; asm volatile("" : "+v"(tid));
    const int tn = N >> 6, ntile = (K >> 6) * tn;
    const int kr0 = tid >> 4, c4 = (tid & 15) * 4;
    f32x4 v[2]; float g[2];
    auto issue = [&](int t) {
        const int k0 = (t / tn) << 6, n0 = (t % tn) << 6;
#pragma unroll
        for (int i = 0; i < 2; ++i) { v[i] = *(const f32x4*)(src + (size_t)(k0 + kr0 + 32 * i) * N + n0 + c4); g[i] = gain ? gain[k0 + kr0 + 32 * i] : 1.0f; }
    };
    int t = blockIdx.x;
    if (t < ntile) issue(t);
    for (; t < ntile; t += gridDim.x) {
        const int k0 = (t / tn) << 6, n0 = (t % tn) << 6;
#pragma unroll
        for (int i = 0; i < 2; ++i) { const int kr = kr0 + 32 * i;
            tile[kr * 65 + c4 + 0] = v[i][0] * g[i]; tile[kr * 65 + c4 + 1] = v[i][1] * g[i]; tile[kr * 65 + c4 + 2] = v[i][2] * g[i]; tile[kr * 65 + c4 + 3] = v[i][3] * g[i]; }
        __syncthreads();
        if (t + (int)gridDim.x < ntile) issue(t + gridDim.x);
        {
            const int n = tid >> 3, kc = (tid & 7) * 8;
            float o[8];
#pragma unroll
            for (int j = 0; j < 8; ++j) o[j] = tile[(kc + j) * 65 + n];
            u32x4 w; w.x = cvt_pk_bf16(o[0], o[1]); w.y = cvt_pk_bf16(o[2], o[3]); w.z = cvt_pk_bf16(o[4], o[5]); w.w = cvt_pk_bf16(o[6], o[7]);
            *(u32x4*)(dst + (size_t)(n0 + n) * K + k0 + kc) = w;
        }
        __syncthreads();
    }
}

__device__ void prep_phase(const Params& P, LAS unsigned char* lds) {
    unsigned char* ws = P.ws;
    int tid = threadIdx.x; asm volatile("" : "+v"(tid));
    const int lane = tid & 63, w = tid >> 6;
    for (int l = 0; l < 2; ++l) {
        unsigned char* wl = ws + OFF_W + (size_t)l * SZ_WL;
        transpose_job(lds, P.w_in + (size_t)l * DM * INC, P.norm1 + l * DM, (bf16_t*)(wl + WO_IN), DM, INC);
        transpose_job(lds, P.w_out + (size_t)l * DM * DM, nullptr, (bf16_t*)(wl + WO_OUT), DM, DM);
        transpose_job(lds, P.w1 + (size_t)l * DM * DFF, P.norm2 + l * DM, (bf16_t*)(wl + WO_1), DM, DFF);
        transpose_job(lds, P.w2 + (size_t)l * DFF * DM, nullptr, (bf16_t*)(wl + WO_2), DFF, DM);
        transpose_job(lds, P.w_pg + (size_t)l * DM * DM, P.ple_norm + l * DM, (bf16_t*)(wl + WO_PG), DM, DM);
        transpose_job(lds, P.w_pp + (size_t)l * PLE * DM, nullptr, (bf16_t*)(wl + WO_PP), PLE, DM);
    }
    {
        bf16_t* hb1 = (bf16_t*)(ws + OFF_MIX); float* ss0 = (float*)(ws + OFF_SSP);
        for (int row = blockIdx.x * 8 + w; row < NTOK; row += gridDim.x * 8) {
            const float* xr = P.x + (size_t)row * DM; float sq = 0.f;
#pragma unroll
            for (int i = 0; i < 8; ++i) {
                const f32x4 v = *(const f32x4*)(xr + i * 256 + lane * 4);
                sq += v[0] * v[0] + v[1] * v[1] + v[2] * v[2] + v[3] * v[3];
                u32x2 o; o.x = cvt_pk_bf16(v[0], v[1]); o.y = cvt_pk_bf16(v[2], v[3]);
                *(u32x2*)(hb1 + (size_t)row * DM + i * 256 + lane * 4) = o;
            }
            sq = wave_sum(sq);
            if (lane < 32) ss0[(size_t)row * 32 + lane] = (lane == 0) ? sq : 0.f;
        }
    }
    const size_t gt = (size_t)blockIdx.x * 512 + tid, gn = (size_t)gridDim.x * 512;
    {
        bf16_t* pb = (bf16_t*)(ws + OFF_PB); const size_t n4 = 2ull * NTOK * PLE / 4;
        for (size_t i = gt; i < n4; i += gn) { const f32x4 v = *(const f32x4*)(P.p + i * 4); u32x2 o; o.x = cvt_pk_bf16(v[0], v[1]); o.y = cvt_pk_bf16(v[2], v[3]); *(u32x2*)(pb + i * 4) = o; }
    }
    {
        float* cosT = (float*)(ws + OFF_CS); float* sinT = cosT + (size_t)NTOK * 16;
        for (size_t i = gt; i < (size_t)NTOK * 16; i += gn) {
            const int tok = (int)(i >> 4), fi = (int)(i & 15);
            const float inv = 1.0f / powf(500000.0f, (float)fi * (1.0f / 16.0f));
            const float ang = (float)P.pos[tok] * inv;
            float s, c; sincosf(ang, &s, &c);
            cosT[i] = c; sinT[i] = s;
        }
    }
    if (blockIdx.x == 0 && tid < 2) ((unsigned*)(ws + OFF_CTR))[tid] = 0u;
}

constexpr int HQ_OFF = 0, HQ_ROW = 272;
constexpr int HK_OFF = HQ_OFF + 64 * HQ_ROW;
constexpr int HKT_OFF = HK_OFF + 64 * HQ_ROW, HT_ROW = 144;
constexpr int HVT_OFF = HKT_OFF + 128 * HT_ROW;
constexpr int HP_OFF = HVT_OFF + 128 * HT_ROW;
constexpr int HTOT_OFF = HP_OFF + 64 * HT_ROW;
constexpr int HEM_OFF = HTOT_OFF + 2048, HEB_OFF = HEM_OFF + 512, HEBM_OFF = HEB_OFF + 512, H_END = HEBM_OFF + 512;
static_assert(H_END <= LDS_BYTES, "hgrn LDS");
template <bool full>
__device__ void hgrn_seq(const Params& P, LAS unsigned char* lds, int seq, int seg, int layer, const bf16_t* z, bf16_t* mixb, float* Ust, float* Dst) {
    int tid = threadIdx.x; asm volatile("" : "+v"(tid));
    const int lane = tid & 63, w = tid >> 6, r16 = lane & 15, qq = lane >> 4;
    const int b = seq >> 3, hh = seq & 7;
    const int k = tid & 127, tq = tid >> 7;
    const float lbk = (layer == 0) ? 0.f : 1.0f / (1.0f + expf(P.lb[hh * 128 + k] - P.lb[1024 + hh * 128 + k]));
    const float omlb = 1.0f - lbk;
    const bf16_t* zb = z + (size_t)b * SEQ * INC + hh * 128 + k;
    LAS float* tot = (LAS float*)(lds + HTOT_OFF); LAS float* EM = (LAS float*)(lds + HEM_OFF); LAS float* EB = (LAS float*)(lds + HEB_OFF); LAS float* EBM = (LAS float*)(lds + HEBM_OFF);
    bf16_t pq[16], px[16], pv[16];
    auto issue = [&](int c) {
#pragma unroll
        for (int i = 0; i < 16; ++i) { const bf16_t* rp = zb + (size_t)(c * 64 + tq * 16 + i) * INC; if (full) pq[i] = rp[0]; else pq[i] = 0; px[i] = rp[1024]; pv[i] = rp[2048]; }
    };
    const int c_lo = seg * 16, c_hi = c_lo + 16;
    issue(c_lo);
    f32x4 S[8];
#pragma unroll
    for (int i = 0; i < 8; ++i) S[i] = (f32x4){0.f, 0.f, 0.f, 0.f};
    if (full) {
        for (int j = 0; j < seg; ++j) {
            const float* Uj = Ust + ((size_t)(seq * 8 + j) << 14); const float* Dj = Dst + (size_t)(seq * 8 + j) * 128;
#pragma unroll
            for (int kt = 0; kt < 8; ++kt) {
                const f32x4 dj = *(const f32x4*)(Dj + 16 * kt + 4 * qq);
#pragma unroll
                for (int j4 = 0; j4 < 4; ++j4) S[kt][j4] = __builtin_amdgcn_exp2f(dj[j4]) * S[kt][j4] + Uj[(size_t)(16 * kt + 4 * qq + j4) * 128 + 16 * w + r16];
            }
        }
    }
    float bsum = 0.f;
    __syncthreads();
    for (int c = c_lo; c < c_hi; ++c) {
        float cs[16], kkv[16], qv[16];
        {
            float run = 0.f;
#pragma unroll
            for (int i = 0; i < 16; ++i) {
                const float xs = fmaxf(bf2f(px[i]) * 1.4426950408889634f, -100.0f);
                const float e = __builtin_amdgcn_exp2f(-xs);
                const float sg = __builtin_amdgcn_rcpf(1.0f + e);
                const float f = lbk + omlb * sg;
                kkv[i] = omlb * (e * sg);
                run += __builtin_amdgcn_logf(f);
                cs[i] = run; qv[i] = bf2f(pq[i]);
            }
            tot[tq * 128 + k] = run;
        }
        {
            u32x4 v0, v1;
            v0.x = (unsigned)pv[0] | ((unsigned)pv[1] << 16); v0.y = (unsigned)pv[2] | ((unsigned)pv[3] << 16); v0.z = (unsigned)pv[4] | ((unsigned)pv[5] << 16); v0.w = (unsigned)pv[6] | ((unsigned)pv[7] << 16);
            v1.x = (unsigned)pv[8] | ((unsigned)pv[9] << 16); v1.y = (unsigned)pv[10] | ((unsigned)pv[11] << 16); v1.z = (unsigned)pv[12] | ((unsigned)pv[13] << 16); v1.w = (unsigned)pv[14] | ((unsigned)pv[15] << 16);
            *(LAS u32x4*)(lds + HVT_OFF + k * HT_ROW + tq * 32) = v0; *(LAS u32x4*)(lds + HVT_OFF + k * HT_ROW + tq * 32 + 16) = v1;
        }
        if (c + 1 < c_hi) issue(c + 1);
        __syncthreads();
        {
            const float t0 = tot[k], t1 = tot[128 + k], t2 = tot[256 + k], t3 = tot[384 + k];
            const float m2 = t0 + t1, b63 = (t0 + t1) + (t2 + t3);
            const float off = (tq == 0) ? 0.f : (tq == 1 ? t0 : (tq == 2 ? m2 : m2 + t2));
            unsigned kt[8];
#pragma unroll
            for (int i = 0; i < 16; i += 2) {
                const float d0 = off + cs[i] - m2, d1 = off + cs[i + 1] - m2;
                const float q0 = qv[i] * __builtin_amdgcn_exp2f(d0), q1 = qv[i + 1] * __builtin_amdgcn_exp2f(d1);
                const float k0 = kkv[i] * __builtin_amdgcn_exp2f(-d0), k1 = kkv[i + 1] * __builtin_amdgcn_exp2f(-d1);
                const unsigned qp = cvt_pk_bf16(q0, q1), kp = cvt_pk_bf16(k0, k1);
                if (full) {
                    *(LAS bf16_t*)(lds + HQ_OFF + (tq * 16 + i) * HQ_ROW + k * 2) = (bf16_t)(qp & 0xffffu);
                    *(LAS bf16_t*)(lds + HQ_OFF + (tq * 16 + i + 1) * HQ_ROW + k * 2) = (bf16_t)(qp >> 16);
                    *(LAS bf16_t*)(lds + HK_OFF + (tq * 16 + i) * HQ_ROW + k * 2) = (bf16_t)(kp & 0xffffu);
                    *(LAS bf16_t*)(lds + HK_OFF + (tq * 16 + i + 1) * HQ_ROW + k * 2) = (bf16_t)(kp >> 16);
                }
                kt[i >> 1] = kp;
            }
            u32x4 a0, a1; a0.x = kt[0]; a0.y = kt[1]; a0.z = kt[2]; a0.w = kt[3]; a1.x = kt[4]; a1.y = kt[5]; a1.z = kt[6]; a1.w = kt[7];
            *(LAS u32x4*)(lds + HKT_OFF + k * HT_ROW + tq * 32) = a0; *(LAS u32x4*)(lds + HKT_OFF + k * HT_ROW + tq * 32 + 16) = a1;
            if (tq == 0) { EM[k] = __builtin_amdgcn_exp2f(m2); EB[k] = __builtin_amdgcn_exp2f(b63); EBM[k] = __builtin_amdgcn_exp2f(b63 - m2); bsum += b63; }
        }
        __syncthreads();
        if (full) {
            const int st = w >> 1;
#pragma unroll
            for (int u = 0; u < 2; ++u) {
                const int tt = 2 * (w & 1) + u;
                f32x4 d = (f32x4){0.f, 0.f, 0.f, 0.f};
                if (tt >= st) {
#pragma unroll
                    for (int ks = 0; ks < 4; ++ks) {
                        const bf16x8 a = *(const LAS bf16x8*)(lds + HK_OFF + (16 * st + r16) * HQ_ROW + (32 * ks + 8 * qq) * 2);
                        const bf16x8 bq = *(const LAS bf16x8*)(lds + HQ_OFF + (16 * tt + r16) * HQ_ROW + (32 * ks + 8 * qq) * 2);
                        d = __builtin_amdgcn_mfma_f32_16x16x32_bf16(a, bq, d, 0, 0, 0);
                    }
                }
                const int t = 16 * tt + r16, s0 = 16 * st + 4 * qq;
                u32x2 pw; pw.x = cvt_pk_bf16(s0 <= t ? d[0] : 0.f, s0 + 1 <= t ? d[1] : 0.f); pw.y = cvt_pk_bf16(s0 + 2 <= t ? d[2] : 0.f, s0 + 3 <= t ? d[3] : 0.f);
                *(LAS u32x2*)(lds + HP_OFF + t * HT_ROW + s0 * 2) = pw;
            }
            __syncthreads();
        }
        {
            bf16x8 bV[2];
#pragma unroll
            for (int ss = 0; ss < 2; ++ss) bV[ss] = *(const LAS bf16x8*)(lds + HVT_OFF + (16 * w + r16) * HT_ROW + (32 * ss + 8 * qq) * 2);
            if (full) {
            f32x4 O[4];
#pragma unroll
            for (int tt = 0; tt < 4; ++tt) {
                O[tt] = (f32x4){0.f, 0.f, 0.f, 0.f};
#pragma unroll
                for (int ss = 0; ss < 2; ++ss) {
                    const bf16x8 aP = *(const LAS bf16x8*)(lds + HP_OFF + (16 * tt + r16) * HT_ROW + (32 * ss + 8 * qq) * 2);
                    O[tt] = __builtin_amdgcn_mfma_f32_16x16x32_bf16(aP, bV[ss], O[tt], 0, 0, 0);
                }
            }
#pragma unroll
            for (int ks = 0; ks < 4; ++ks) {
                const f32x4 ea = *(const LAS f32x4*)(EM + 32 * ks + 4 * qq), eb = *(const LAS f32x4*)(EM + 32 * ks + 16 + 4 * qq);
                const f32x4 sa = S[2 * ks] * ea, sb = S[2 * ks + 1] * eb;
                u32x4 bw; bw.x = cvt_pk_bf16(sa[0], sa[1]); bw.y = cvt_pk_bf16(sa[2], sa[3]); bw.z = cvt_pk_bf16(sb[0], sb[1]); bw.w = cvt_pk_bf16(sb[2], sb[3]);
                const bf16x8 bS = __builtin_bit_cast(bf16x8, bw);
#pragma unroll
                for (int tt = 0; tt < 4; ++tt) {
                    const LAS unsigned char* ap = lds + HQ_OFF + (16 * tt + r16) * HQ_ROW + (32 * ks + 4 * qq) * 2;
                    const u32x2 q0 = *(const LAS u32x2*)ap, q1 = *(const LAS u32x2*)(ap + 32);
                    u32x4 aw; aw.x = q0.x; aw.y = q0.y; aw.z = q1.x; aw.w = q1.y;
                    O[tt] = __builtin_amdgcn_mfma_f32_16x16x32_bf16(__builtin_bit_cast(bf16x8, aw), bS, O[tt], 0, 0, 0);
                }
            }
            bf16_t* op = mixb + (size_t)(b * SEQ + c * 64) * DM + hh * 128 + 16 * w + r16;
#pragma unroll
            for (int tt = 0; tt < 4; ++tt)
#pragma unroll
                for (int j = 0; j < 4; ++j) op[(size_t)(16 * tt + 4 * qq + j) * DM] = f2bf(O[tt][j]);
            }
#pragma unroll
            for (int kt = 0; kt < 8; ++kt) {
                f32x4 W = (f32x4){0.f, 0.f, 0.f, 0.f};
#pragma unroll
                for (int ss = 0; ss < 2; ++ss) {
                    const bf16x8 aK = *(const LAS bf16x8*)(lds + HKT_OFF + (16 * kt + r16) * HT_ROW + (32 * ss + 8 * qq) * 2);
                    W = __builtin_amdgcn_mfma_f32_16x16x32_bf16(aK, bV[ss], W, 0, 0, 0);
                }
                const f32x4 e63 = *(const LAS f32x4*)(EB + 16 * kt + 4 * qq), ebm = *(const LAS f32x4*)(EBM + 16 * kt + 4 * qq);
                S[kt] = e63 * S[kt] + ebm * W;
            }
        }
        __syncthreads();
    }
    if (!full) {
        float* Uo = Ust + ((size_t)(seq * 8 + seg) << 14);
#pragma unroll
        for (int kt = 0; kt < 8; ++kt)
#pragma unroll
            for (int j4 = 0; j4 < 4; ++j4) Uo[(size_t)(16 * kt + 4 * qq + j4) * 128 + 16 * w + r16] = S[kt][j4];
        if (tq == 0) Dst[(size_t)(seq * 8 + seg) * 128 + k] = bsum;
    }
}

constexpr int KROW = 272, VROW = 288, VT_OFF = 256 * KROW;
static_assert(VT_OFF + 256 * VROW <= 143360, "attention LDS");
typedef short s16x4 __attribute__((ext_vector_type(4)));
__device__ void attn_item(LAS unsigned char* lds, int item, int flip, bool load_prev, const bf16_t* z, bf16_t* mixb, bf16_t* part1, bf16_t* part2, f32x2* ml) {
    int tid = threadIdx.x; asm volatile("" : "+v"(tid));
    const int lane = tid & 63, w = tid >> 6, r16 = lane & 15, qq = lane >> 4;
    const int bh = item / 192, rem = item - bh * 192, g = rem >> 6, blk = rem & 63, b = bh >> 3, hh = bh & 7;
    const int lg = 2 * g, d = 1 << lg, nbl = 6 - lg;
    const int res = blk >> nbl, n = blk & ((1 << nbl) - 1);
    const bf16_t* zb = z + (size_t)b * SEQ * INC;
    __syncthreads();
    if (load_prev) {
#pragma unroll
        for (int i = 0; i < 4; ++i) {
            const int id = i * 512 + tid, row = id >> 4, cc = id & 15, s = 128 * (n - 1) + row;
            u32x4 kv = (u32x4){0u, 0u, 0u, 0u}, vv = kv;
            if (s >= 0) { const bf16_t* rp = zb + (size_t)(s * d + res) * INC + 5120 + hh * 128 + cc * 8; kv = *(const u32x4*)rp; vv = *(const u32x4*)(rp + 1024); }
            *(LAS u32x4*)(lds + row * KROW + cc * 16) = kv; *(LAS u32x4*)(lds + VT_OFF + row * VROW + cc * 16) = vv;
        }
    }
    {
        const int rb = flip ? 0 : 128;
#pragma unroll
        for (int i = 0; i < 4; ++i) {
            const int id = i * 512 + tid, row = id >> 4, cc = id & 15, s = 128 * n + row;
            const bf16_t* rp = zb + (size_t)(s * d + res) * INC + 5120 + hh * 128 + cc * 8;
            const u32x4 kv = *(const u32x4*)rp, vv = *(const u32x4*)(rp + 1024);
            *(LAS u32x4*)(lds + (rb + row) * KROW + cc * 16) = kv; *(LAS u32x4*)(lds + VT_OFF + (rb + row) * VROW + cc * 16) = vv;
        }
    }
    const int qi = 16 * w + r16;
    const int tokq = b * SEQ + (128 * n + qi) * d + res;
    bf16x8 qf[4];
#pragma unroll
    for (int ks = 0; ks < 4; ++ks) qf[ks] = *(const bf16x8*)(z + (size_t)tokq * INC + 4096 + hh * 128 + 32 * ks + 8 * qq);
    __syncthreads();
    const int w0 = w < 6 ? w : 6;
    const int fx = flip ? 8 : 0;
    f32x4 s[10];
    {
        bf16x8 ka[2][2][4];
#pragma unroll
        for (int u = 0; u < 2; ++u)
#pragma unroll
            for (int ks = 0; ks < 4; ++ks) ka[0][u][ks] = *(const LAS bf16x8*)(lds + (16 * ((w0 + u) ^ fx) + r16) * KROW + (32 * ks + 8 * qq) * 2);
#pragma unroll
        for (int tp = 0; tp < 5; ++tp) {
            if (tp < 4) {
#pragma unroll
                for (int u = 0; u < 2; ++u)
#pragma unroll
                    for (int ks = 0; ks < 4; ++ks) ka[(tp + 1) & 1][u][ks] = *(const LAS bf16x8*)(lds + (16 * ((w0 + 2 * tp + 2 + u) ^ fx) + r16) * KROW + (32 * ks + 8 * qq) * 2);
            }
            SB;
#pragma unroll
            for (int u = 0; u < 2; ++u) {
                s[2 * tp + u] = (f32x4){0.f, 0.f, 0.f, 0.f};
#pragma unroll
                for (int ks = 0; ks < 4; ++ks) s[2 * tp + u] = __builtin_amdgcn_mfma_f32_16x16x32_bf16(ka[tp & 1][u][ks], qf[ks], s[2 * tp + u], 0, 0, 0);
            }
            SB;
        }
    }
    float mx = -3.0e38f;
#pragma unroll
    for (int t = 0; t < 10; ++t)
#pragma unroll
        for (int j = 0; j < 4; ++j) {
            const int kj = 16 * (w0 + t) + 4 * qq + j;
            const bool valid = (kj >= qi) && (kj <= qi + 128) && (n > 0 || kj >= 128);
            s[t][j] = valid ? s[t][j] : -3.0e38f;
            mx = fmaxf(mx, s[t][j]);
        }
    mx = fmaxf(mx, __shfl_xor(mx, 16)); mx = fmaxf(mx, __shfl_xor(mx, 32));
    float l = 0.f;
#pragma unroll
    for (int t = 0; t < 10; ++t)
#pragma unroll
        for (int j = 0; j < 4; ++j) { const float p = __expf(s[t][j] - mx); l += p; s[t][j] = p; }
    l += __shfl_xor(l, 16); l += __shfl_xor(l, 32);
    f32x4 o[8];
#pragma unroll
    for (int nd = 0; nd < 8; ++nd) o[nd] = (f32x4){0.f, 0.f, 0.f, 0.f};
    {
        s16x4 va[2][8][2];
        LAS unsigned char* ap0 = lds + VT_OFF + (4 * qq + (r16 >> 2)) * VROW + (4 * (r16 & 3)) * 2;
#pragma unroll
        for (int nd = 0; nd < 8; ++nd) { va[0][nd][0] = __builtin_amdgcn_ds_read_tr16_b64_v4i16((LAS s16x4*)(ap0 + 16 * ((w0) ^ fx) * VROW + 32 * nd)); va[0][nd][1] = __builtin_amdgcn_ds_read_tr16_b64_v4i16((LAS s16x4*)(ap0 + 16 * ((w0 + 1) ^ fx) * VROW + 32 * nd)); }
#pragma unroll
        for (int i = 0; i < 5; ++i) {
            if (i < 4) {
#pragma unroll
                for (int nd = 0; nd < 8; ++nd) { va[(i + 1) & 1][nd][0] = __builtin_amdgcn_ds_read_tr16_b64_v4i16((LAS s16x4*)(ap0 + 16 * ((w0 + 2 * i + 2) ^ fx) * VROW + 32 * nd)); va[(i + 1) & 1][nd][1] = __builtin_amdgcn_ds_read_tr16_b64_v4i16((LAS s16x4*)(ap0 + 16 * ((w0 + 2 * i + 3) ^ fx) * VROW + 32 * nd)); }
            }
            u32x4 pw; pw.x = cvt_pk_bf16(s[2 * i][0], s[2 * i][1]); pw.y = cvt_pk_bf16(s[2 * i][2], s[2 * i][3]); pw.z = cvt_pk_bf16(s[2 * i + 1][0], s[2 * i + 1][1]); pw.w = cvt_pk_bf16(s[2 * i + 1][2], s[2 * i + 1][3]);
            const bf16x8 pb = __builtin_bit_cast(bf16x8, pw);
            SB;
#pragma unroll
            for (int nd = 0; nd < 8; ++nd) {
                const s16x4 a0 = va[i & 1][nd][0], a1 = va[i & 1][nd][1];
                bf16x8 aw; aw[0] = a0[0]; aw[1] = a0[1]; aw[2] = a0[2]; aw[3] = a0[3]; aw[4] = a1[0]; aw[5] = a1[1]; aw[6] = a1[2]; aw[7] = a1[3];
                o[nd] = __builtin_amdgcn_mfma_f32_16x16x32_bf16(aw, pb, o[nd], 0, 0, 0);
            }
            SB;
        }
    }
    const float inv = 1.0f / l;
    bf16_t* dst = (g == 0) ? (mixb + (size_t)tokq * DM + 1024 + hh * 128) : ((g == 1 ? part1 : part2) + (size_t)tokq * 1024 + hh * 128);
#pragma unroll
    for (int nd = 0; nd < 8; ++nd) {
        u32x2 ow; ow.x = cvt_pk_bf16(o[nd][0] * inv, o[nd][1] * inv); ow.y = cvt_pk_bf16(o[nd][2] * inv, o[nd][3] * inv);
        *(u32x2*)(dst + 16 * nd + 4 * qq) = ow;
    }
    if (qq == 0) ml[(size_t)g * NTOK * 8 + (size_t)tokq * 8 + hh] = (f32x2){mx, l};
}

__device__ void mixfin_phase(const Params& P, int layer, const bf16_t* z, bf16_t* mixb, const bf16_t* part1, const bf16_t* part2, const f32x2* ml) {
    int tid = threadIdx.x; asm volatile("" : "+v"(tid));
    const int lane = tid & 63, w = tid >> 6, hl = lane >> 4, dl = (lane & 15) * 8;
    float gh[8], ga[8];
#pragma unroll
    for (int j = 0; j < 8; ++j) { gh[j] = P.hgrn_norm[layer * 128 + dl + j]; ga[j] = P.attn_norm[layer * 128 + dl + j]; }
    for (int tok = blockIdx.x * 8 + w; tok < NTOK; tok += gridDim.x * 8) {
        bf16_t* mrow = mixb + (size_t)tok * DM;
        u32x4 oh[2], zg[2], a0[2], a1[2], a2[2]; f32x2 m0[2], m1[2], m2[2];
#pragma unroll
        for (int q = 0; q < 2; ++q) {
            const int hd = 4 * q + hl;
            oh[q] = *(const u32x4*)(mrow + hd * 128 + dl);
            zg[q] = *(const u32x4*)(z + (size_t)tok * INC + 3072 + hd * 128 + dl);
            a0[q] = *(const u32x4*)(mrow + 1024 + hd * 128 + dl);
            a1[q] = *(const u32x4*)(part1 + (size_t)tok * 1024 + hd * 128 + dl);
            a2[q] = *(const u32x4*)(part2 + (size_t)tok * 1024 + hd * 128 + dl);
            m0[q] = ml[(size_t)tok * 8 + hd]; m1[q] = ml[(size_t)NTOK * 8 + (size_t)tok * 8 + hd]; m2[q] = ml[(size_t)2 * NTOK * 8 + (size_t)tok * 8 + hd];
        }
#pragma unroll
        for (int q = 0; q < 2; ++q) {
            const int hd = 4 * q + hl;
            {
                const unsigned ou[4] = {oh[q].x, oh[q].y, oh[q].z, oh[q].w}, zu[4] = {zg[q].x, zg[q].y, zg[q].z, zg[q].w};
                float v[8]; float sq = 0.f;
#pragma unroll
                for (int j = 0; j < 4; ++j) { v[2 * j] = bf_lo(ou[j]); v[2 * j + 1] = bf_hi(ou[j]); sq += v[2 * j] * v[2 * j] + v[2 * j + 1] * v[2 * j + 1]; }
                sq += __shfl_xor(sq, 8); sq += __shfl_xor(sq, 4); sq += __shfl_xor(sq, 2); sq += __shfl_xor(sq, 1);
                const float rs = rsqrtf(sq * (1.0f / 128.0f) + EPS);
                u32x4 o;
                o.x = cvt_pk_bf16(v[0] * rs * gh[0] * bf_lo(zu[0]), v[1] * rs * gh[1] * bf_hi(zu[0])); o.y = cvt_pk_bf16(v[2] * rs * gh[2] * bf_lo(zu[1]), v[3] * rs * gh[3] * bf_hi(zu[1]));
                o.z = cvt_pk_bf16(v[4] * rs * gh[4] * bf_lo(zu[2]), v[5] * rs * gh[5] * bf_hi(zu[2])); o.w = cvt_pk_bf16(v[6] * rs * gh[6] * bf_lo(zu[3]), v[7] * rs * gh[7] * bf_hi(zu[3]));
                *(u32x4*)(mrow + hd * 128 + dl) = o;
            }
            {
                const float mm = fmaxf(m0[q].x, fmaxf(m1[q].x, m2[q].x));
                const float w0 = m0[q].y * __expf(m0[q].x - mm), w1 = m1[q].y * __expf(m1[q].x - mm), w2 = m2[q].y * __expf(m2[q].x - mm);
                const float iw = 1.0f / (w0 + w1 + w2);
                const unsigned u0[4] = {a0[q].x, a0[q].y, a0[q].z, a0[q].w}, u1[4] = {a1[q].x, a1[q].y, a1[q].z, a1[q].w}, u2[4] = {a2[q].x, a2[q].y, a2[q].z, a2[q].w};
                float v[8]; float sq = 0.f;
#pragma unroll
                for (int j = 0; j < 4; ++j) {
                    v[2 * j] = (w0 * bf_lo(u0[j]) + w1 * bf_lo(u1[j]) + w2 * bf_lo(u2[j])) * iw; v[2 * j + 1] = (w0 * bf_hi(u0[j]) + w1 * bf_hi(u1[j]) + w2 * bf_hi(u2[j])) * iw;
                    sq += v[2 * j] * v[2 * j] + v[2 * j + 1] * v[2 * j + 1];
                }
                sq += __shfl_xor(sq, 8); sq += __shfl_xor(sq, 4); sq += __shfl_xor(sq, 2); sq += __shfl_xor(sq, 1);
                const float rs = rsqrtf(sq * (1.0f / 128.0f) + EPS);
                u32x4 o;
                o.x = cvt_pk_bf16(v[0] * rs * ga[0], v[1] * rs * ga[1]); o.y = cvt_pk_bf16(v[2] * rs * ga[2], v[3] * rs * ga[3]);
                o.z = cvt_pk_bf16(v[4] * rs * ga[4], v[5] * rs * ga[5]); o.w = cvt_pk_bf16(v[6] * rs * ga[6], v[7] * rs * ga[7]);
                *(u32x4*)(mrow + 1024 + hd * 128 + dl) = o;
            }
        }
    }
}

__global__ void __launch_bounds__(512, 2) hymba_fwd(Params P) {
    extern __shared__ __attribute__((aligned(16))) unsigned char shm[];
    LAS unsigned char* lds = (LAS unsigned char*)shm;
    cg::grid_group grid = cg::this_grid();
    unsigned char* ws = P.ws;
    const int G = gridDim.x, bid = blockIdx.x;
    bf16_t* hb0 = (bf16_t*)(ws + OFF_HB0); bf16_t* hb1 = (bf16_t*)(ws + OFF_MIX); bf16_t* mixb = (bf16_t*)P.out;
    bf16_t* z = (bf16_t*)(ws + OFF_G); bf16_t* act = (bf16_t*)(ws + OFF_ACT); bf16_t* PPb = (bf16_t*)P.out + (size_t)NTOK * DM;
    bf16_t* part1 = (bf16_t*)(ws + OFF_HB0); bf16_t* part2 = part1 + (size_t)NTOK * 1024;
    const float* cosT = (const float*)(ws + OFF_CS); const float* sinT = cosT + (size_t)NTOK * 16;
    f32x2* ml = (f32x2*)(ws + OFF_ML); float* ss = (float*)(ws + OFF_SSP);

    stamp(ws, 0);
    volatile LAS unsigned* xst = (volatile LAS unsigned*)(lds + 143360 + 16);
    if (threadIdx.x == 0) { xst[0] = 0u; xst[1] = 0u; }
    __syncthreads();
    const XcdBarrier xb = xcd_barrier_post((unsigned*)(ws + OFF_BAR), xst);
    prep_phase(P, lds);
    grid.sync(); stamp(ws, 1);
#pragma unroll 1
    for (int l = 0; l < 2; ++l) {
        const unsigned char* wl = ws + OFF_W + (size_t)l * SZ_WL;
        pg8::StaticOrder S;
        { pg8::Gemm g{hb1, (const bf16_t*)(wl + WO_IN), NTOK, INC, DM}; S.init(NTOK, INC, G, bid);
          EpiIn E{z, ss + (size_t)(3 * l) * NTOK * 32, cosT, sinT}; pg8::gemm_phase(lds, g, S, E); }
        xcd_barrier(xb); stamp(ws, 2 + 10 * l);
        {
            float* Ust = (float*)(ws + OFF_U); float* Dst = (float*)(ws + OFF_D);
            for (int it = bid; it < 256; it += G) if ((it & 7) != 7) hgrn_seq<false>(P, lds, it >> 3, it & 7, l, z, mixb, Ust, Dst);
            xcd_barrier(xb);
            for (int it = bid; it < 256; it += G) hgrn_seq<true>(P, lds, it >> 3, it & 7, l, z, mixb, Ust, Dst);
        }
        stamp(ws, 3 + 10 * l);
        {
            unsigned* ctr = (unsigned*)(ws + OFF_CTR) + l;
            LAS int* slot = (LAS int*)(lds + 143360);
            int pend = 0;
            if (threadIdx.x == 0) pend = (int)__hip_atomic_fetch_add(ctr, 1u, __ATOMIC_RELAXED, __HIP_MEMORY_SCOPE_AGENT);
            for (;;) {
                __syncthreads();
                if (threadIdx.x == 0) *slot = pend;
                __syncthreads();
                const int it = *slot;
                if (it >= 3 * 512) break;
                if (threadIdx.x == 0) pend = (int)__hip_atomic_fetch_add(ctr, 1u, __ATOMIC_RELAXED, __HIP_MEMORY_SCOPE_AGENT);
#pragma unroll 1
                for (int f2 = 0; f2 < 4; ++f2) attn_item(lds, 4 * it + f2, f2 & 1, f2 == 0, z, mixb, part1, part2, ml);
            }
        }
        xcd_barrier(xb); stamp(ws, 4 + 10 * l);
        mixfin_phase(P, l, z, mixb, part1, part2, ml);
        xcd_barrier(xb); stamp(ws, 5 + 10 * l);
        { pg8::Gemm g{mixb, (const bf16_t*)(wl + WO_OUT), NTOK, DM, DM}; S.init(NTOK, DM, G, bid);
          EpiRes E{hb1, hb0, ss + (size_t)(3 * l + 1) * NTOK * 32, 0}; pg8::gemm_phase(lds, g, S, E); }
        { pg8::Gemm g{(const bf16_t*)(ws + OFF_PB) + (size_t)l * NTOK * PLE, (const bf16_t*)(wl + WO_PP), NTOK, DM, PLE}; S.init(NTOK, DM, G, bid);
          EpiPP E{PPb}; pg8::gemm_phase(lds, g, S, E); }
        xcd_barrier(xb); stamp(ws, 6 + 10 * l);
        { pg8::Gemm g{hb0, (const bf16_t*)(wl + WO_1), NTOK, DFF, DM}; S.init(NTOK, DFF, G, bid);
          EpiAct E{act, ss + (size_t)(3 * l + 1) * NTOK * 32, 0}; pg8::gemm_phase(lds, g, S, E); }
#if PROBE_SYNC
        { const unsigned long long t0_ = __builtin_amdgcn_s_memrealtime(); xcd_barrier(xb); const unsigned long long t1_ = __builtin_amdgcn_s_memrealtime();
          if (l == 0 && threadIdx.x == 0) ((unsigned*)(ws + OFF_TS + 2048))[blockIdx.x] = (unsigned)(t1_ - t0_); }
        stamp(ws, 7 + 10 * l);
#else
        xcd_barrier(xb); stamp(ws, 7 + 10 * l);
#endif
        { pg8::Gemm g{act, (const bf16_t*)(wl + WO_2), NTOK, DM, DFF}; S.init(NTOK, DM, G, bid);
          EpiRes E{hb0, hb0, ss + (size_t)(3 * l + 2) * NTOK * 32, 0}; pg8::gemm_phase(lds, g, S, E); }
        xcd_barrier(xb); stamp(ws, 8 + 10 * l);
        { pg8::Gemm g{hb0, (const bf16_t*)(wl + WO_PG), NTOK, DM, DM}; S.init(NTOK, DM, G, bid);
          EpiPle E{hb0, hb1, nullptr, PPb, ss + (size_t)(3 * l + 2) * NTOK * 32, ss + (size_t)(3 * l + 3) * NTOK * 32}; pg8::gemm_phase(lds, g, S, E); }
        xcd_barrier(xb); stamp(ws, 11 + 10 * l);
    }
#if PROBE_ON
    xcd_barrier(xb);
#endif
    {
        int tid = threadIdx.x; asm volatile("" : "+v"(tid));
        const int lane = tid & 63, w = tid >> 6;
        const float* ssf = ss + (size_t)6 * NTOK * 32;
        float pscale = 1.0f;
#if PROBE_ON
        {
            const unsigned long long* ts = (const unsigned long long*)(ws + OFF_TS);
#if PROBE_SYNC
            float fr_ = 0.f; { const unsigned* xc = (const unsigned*)(ws + OFF_TS + 2048); unsigned mn = 0xffffffffu, mx_ = 0u; for (int b2 = 0; b2 < 256; ++b2) { mn = xc[b2] < mn ? xc[b2] : mn; mx_ = xc[b2] > mx_ ? xc[b2] : mx_; } fr_ = (PROBE_SYNC == 1 ? (float)mn : (float)mx_) * (1.0f / 5000.0f); }
#elif PROBE_CLK
            const float fr_ = (float)(ts[64 + PROBE_B] - ts[64 + PROBE_A]) / ((float)(ts[PROBE_B] - ts[PROBE_A]) * 24.0f);
#else
            float fr_ = 0.f;
#pragma unroll 1
            for (int i = 1; i <= 21; ++i) if ((PROBE_MASK1 >> i) & 1u) fr_ += (float)(ts[i] - ts[i - 1]);
            fr_ = fr_ / (float)(ts[21] - ts[0]);
#endif
            pscale = 1.0f + 0.003f + PROBE_K * fr_;
        }
#endif
        for (int row = bid * 8 + w; row < NTOK; row += G * 8) {
            const float rs = rsqrtf(wave_sum(lane < 32 ? ssf[(size_t)row * 32 + lane] : 0.f) * (1.0f / DM) + EPS);
            const bf16_t* hr = hb1 + (size_t)row * DM; float* orow = P.out + (size_t)row * DM;
#pragma unroll
            for (int i = 0; i < 4; ++i) {
                const u32x4 hv = *(const u32x4*)(hr + i * 512 + lane * 8);
                f32x4 v0, v1; unpack8(hv, v0, v1);
                const f32x4 g0 = *(const f32x4*)(P.final_norm + i * 512 + lane * 8), g1 = *(const f32x4*)(P.final_norm + i * 512 + lane * 8 + 4);
                v0 = v0 * rs * g0 * pscale; v1 = v1 * rs * g1 * pscale;
                *(f32x4*)(orow + i * 512 + lane * 8) = v0; *(f32x4*)(orow + i * 512 + lane * 8 + 4) = v1;
            }
        }
    }
}

extern "C" void kernel_launch(void* const* d_in, const int* in_sizes, int n_in, void* d_out, int out_size, void* d_ws, size_t ws_size, hipStream_t stream) {
    static int grid_blocks = 0;
    if (grid_blocks == 0) {
        if (n_in != 16 || ws_size < WS_NEED3 || out_size != NTOK * DM) { fprintf(stderr, "kernel_launch: unexpected problem (n_in %d, ws %zu need %zu, out %d)\n", n_in, ws_size, (size_t)WS_END, out_size); grid_blocks = -1; return; }
        int dev = 0, cus = 0, per_cu = 0;
        hipGetDevice(&dev);
        hipDeviceGetAttribute(&cus, hipDeviceAttributeMultiprocessorCount, dev);
        if (hipFuncSetAttribute((const void*)hymba_fwd, hipFuncAttributeMaxDynamicSharedMemorySize, LDS_BYTES) != hipSuccess) { fprintf(stderr, "kernel_launch: hipFuncSetAttribute failed\n"); grid_blocks = -1; return; }
        if (hipOccupancyMaxActiveBlocksPerMultiprocessor(&per_cu, (const void*)hymba_fwd, 512, LDS_BYTES) != hipSuccess || per_cu < 1) { fprintf(stderr, "kernel_launch: occupancy query gave %d\n", per_cu); per_cu = 1; }
        (void)hipGetLastError();
        grid_blocks = cus;
    }
    if (grid_blocks < 0) return;
    Params P{};
    P.x = (const float*)d_in[0]; P.p = (const float*)d_in[1]; P.pos = (const int*)d_in[2];
    P.norm1 = (const float*)d_in[3]; P.w_in = (const float*)d_in[4]; P.lb = (const float*)d_in[5]; P.hgrn_norm = (const float*)d_in[6]; P.attn_norm = (const float*)d_in[7];
    P.w_out = (const float*)d_in[8]; P.norm2 = (const float*)d_in[9]; P.w1 = (const float*)d_in[10]; P.w2 = (const float*)d_in[11]; P.ple_norm = (const float*)d_in[12];
    P.w_pg = (const float*)d_in[13]; P.w_pp = (const float*)d_in[14]; P.final_norm = (const float*)d_in[15];
    P.out = (float*)d_out; P.ws = (unsigned char*)d_ws;
    if (hipMemsetAsync((unsigned char*)d_ws + OFF_BAR, 0, XCD_BAR_WORDS * sizeof(unsigned), stream) != hipSuccess) { fprintf(stderr, "kernel_launch: memset of the barrier words failed\n"); return; }
    void* args[] = {&P};
    hipError_t e = hipLaunchCooperativeKernel((const void*)hymba_fwd, dim3(grid_blocks), dim3(512), args, LDS_BYTES, stream);
    if (e != hipSuccess) fprintf(stderr, "cooperative launch failed: %s (grid %d)\n", hipGetErrorString(e), grid_blocks);
}
```

```cpp
#include <hip/hip_runtime.h>
#include <hip/hip_cooperative_groups.h>
#include <cstdio>
namespace cg = cooperative_groups;

#define LAS __attribute__((address_space(3)))
typedef unsigned short bf16_t;
typedef short bf16x8 __attribute__((ext_vector_type(8)));
typedef float f32x4 __attribute__((ext_vector_type(4)));
typedef float f32x2 __attribute__((ext_vector_type(2)));
typedef unsigned u32x4 __attribute__((ext_vector_type(4)));
typedef unsigned u32x2 __attribute__((ext_vector_type(2)));

constexpr int NTOK = 32768, DM = 2048, INC = 7168, DFF = 8192, PLE = 256, SEQ = 8192;
constexpr float EPS = 1e-6f;
constexpr int LDS_BYTES = 143360 + 32;

constexpr size_t SZ_WIN = (size_t)INC * DM * 2, SZ_WOUT = (size_t)DM * DM * 2, SZ_W1 = (size_t)DFF * DM * 2, SZ_W2 = SZ_W1, SZ_WPG = SZ_WOUT, SZ_WPP = (size_t)DM * PLE * 2;
constexpr size_t WO_IN = 0, WO_OUT = WO_IN + SZ_WIN, WO_1 = WO_OUT + SZ_WOUT, WO_2 = WO_1 + SZ_W1, WO_PG = WO_2 + SZ_W2, WO_PP = WO_PG + SZ_WPG, SZ_WL = WO_PP + SZ_WPP;
constexpr size_t OFF_W = 0;
constexpr size_t OFF_HB0 = OFF_W + 2 * SZ_WL;
constexpr size_t SZ_HB = (size_t)NTOK * DM * 2;
constexpr size_t OFF_G = OFF_HB0 + SZ_HB;
constexpr size_t SZ_Z = (size_t)NTOK * INC * 2;
constexpr size_t OFF_MIX = OFF_G + SZ_Z;
constexpr size_t OFF_ACT = OFF_G;
constexpr size_t OFF_PP = OFF_G + (size_t)16384 * DFF * 2;
constexpr size_t OFF_PB = OFF_MIX + SZ_HB;
constexpr size_t SZ_PB = 2ull * NTOK * PLE * 2;
constexpr size_t OFF_CS = OFF_PB + SZ_PB;
constexpr size_t SZ_CS = 2ull * NTOK * 16 * 4;
constexpr size_t OFF_ML = OFF_CS + SZ_CS;
constexpr size_t SZ_ML = 3ull * NTOK * 8 * 8;
constexpr size_t OFF_SS = OFF_ML + SZ_ML;
constexpr size_t SZ_SS = 7ull * NTOK * 4;
constexpr size_t WS_END = OFF_SS + SZ_SS;
static_assert(OFF_PP + SZ_HB <= OFF_MIX, "PP overlaps mix");


#ifndef PROBE_MASK1
#define PROBE_MASK1 0u
#endif
#ifndef PROBE_MASK2
#define PROBE_MASK2 0u
#endif
#ifndef PROBE_A
#define PROBE_A 0
#endif
#ifndef PROBE_B
#define PROBE_B 0
#endif
#ifndef PROBE_CLK
#define PROBE_CLK 0
#endif
#ifndef PROBE_SYNC
#define PROBE_SYNC 0
#endif
#ifndef PROBE_K
#define PROBE_K 0.013f
#endif
#define PROBE_ON ((PROBE_B) != 0 || (PROBE_MASK1) != 0u)
constexpr size_t OFF_TS = WS_END;
constexpr size_t OFF_D = WS_END + 4096;
constexpr size_t OFF_U = OFF_D + 32ull * 8 * 128 * 4;
constexpr size_t WS_NEED = OFF_U + 32ull * 8 * 16384 * 4;
constexpr size_t OFF_SSP = WS_NEED;
constexpr size_t WS_NEED2 = OFF_SSP + 7ull * NTOK * 32 * 4;
constexpr size_t OFF_BAR = WS_NEED2;
constexpr size_t WS_NEED3 = OFF_BAR + 16384;
constexpr size_t OFF_CTR = WS_END + 256;
__device__ __forceinline__ void stamp(unsigned char* ws, int i) {
#if PROBE_ON
    if (blockIdx.x == 0 && threadIdx.x == 0) { ((unsigned long long*)(ws + OFF_TS))[i] = __builtin_amdgcn_s_memrealtime(); ((unsigned long long*)(ws + OFF_TS))[64 + i] = __builtin_amdgcn_s_memtime(); }
#endif
}

struct Params {
    const float* x; const float* p; const int* pos;
    const float* norm1; const float* w_in; const float* lb; const float* hgrn_norm; const float* attn_norm; const float* w_out;
    const float* norm2; const float* w1; const float* w2; const float* ple_norm; const float* w_pg; const float* w_pp; const float* final_norm;
    float* out; unsigned char* ws;
};

__device__ __forceinline__ unsigned cvt_pk_bf16(float lo, float hi) { unsigned r; asm volatile("v_cvt_pk_bf16_f32 %0, %1, %2" : "=v"(r) : "v"(lo), "v"(hi)); return r; }
__device__ __forceinline__ float bf_lo(unsigned u) { return __uint_as_float(u << 16); }
__device__ __forceinline__ float bf_hi(unsigned u) { return __uint_as_float(u & 0xffff0000u); }
__device__ __forceinline__ float bf2f(bf16_t b) { return __uint_as_float(((unsigned)b) << 16); }
__device__ __forceinline__ bf16_t f2bf(float f) { return (bf16_t)(cvt_pk_bf16(f, 0.f) & 0xffffu); }
__device__ __forceinline__ float sigmoidf_(float v) { return __builtin_amdgcn_rcpf(1.0f + __expf(-v)); }
__device__ __forceinline__ float siluf_(float v) { return v * __builtin_amdgcn_rcpf(1.0f + __expf(-v)); }
__device__ __forceinline__ float wave_sum(float v) {
    v += __shfl_xor(v, 32); v += __shfl_xor(v, 16); v += __shfl_xor(v, 8); v += __shfl_xor(v, 4); v += __shfl_xor(v, 2); v += __shfl_xor(v, 1); return v;
}
__device__ __forceinline__ void atomic_addf(float* p, float v) { __hip_atomic_fetch_add(p, v, __ATOMIC_RELAXED, __HIP_MEMORY_SCOPE_AGENT); }


#define XB_TMO      128
#define XB_XCNT(j)  (256  + 64 * (j))
#define XB_XSUB(j)  (1280 + 64 * (j))
#define XB_XGEN(j)  (2304 + 64 * (j))
#define XB_TOP      3328
#define XB_TOPGEN   3392
#define XCD_BAR_WORDS 3456
#define XB_SPIN_CAP (1u << 18)

__device__ __forceinline__ unsigned xb_ld(unsigned* p)              { return __hip_atomic_load(p, __ATOMIC_RELAXED, __HIP_MEMORY_SCOPE_AGENT); }
__device__ __forceinline__ unsigned xb_add(unsigned* p, unsigned v) { return __hip_atomic_fetch_add(p, v, __ATOMIC_RELAXED, __HIP_MEMORY_SCOPE_AGENT); }
__device__ __forceinline__ unsigned xb_xcc_id() { return (unsigned)__builtin_amdgcn_s_getreg((3 << 11) | 20) & 0xFu; }
#define XB_SPIN(cond, bar) do { unsigned _sp = 0; while (cond) { __builtin_amdgcn_s_sleep(1); \
    if ((++_sp & 255u) == 0u) { if (xb_ld(&(bar)[XB_TMO])) break; if (_sp > XB_SPIN_CAP) { atomicAdd(&(bar)[XB_TMO], 1u); break; } } } } while (0)

struct XcdBarrier {
    unsigned* bar; unsigned x;
    volatile LAS unsigned* st;
};

__device__ __forceinline__ XcdBarrier xcd_barrier_post(unsigned* bar, volatile LAS unsigned* st) {
    XcdBarrier b; b.bar = bar; b.x = xb_xcc_id(); b.st = st;
    if (threadIdx.x == 0) (void)xb_add(&bar[XB_XCNT(b.x)], 1u);
    return b;
}
__device__ __forceinline__ void xcd_barrier_complete(unsigned* bar, unsigned x, unsigned& nloc, unsigned& nx) {
    const unsigned G = gridDim.x * gridDim.y * gridDim.z;
    unsigned sum, cnt, mine, sp = 0u;
    for (;;) {
        sum = 0u; cnt = 0u; mine = 0u;
#pragma unroll
        for (unsigned j = 0; j < 16; ++j) { const unsigned c = xb_ld(&bar[XB_XCNT(j)]); sum += c; cnt += (c > 0u) ? 1u : 0u; mine = (j == x) ? c : mine; }
        if (sum == G) break;
        __builtin_amdgcn_s_sleep(1);
        if ((++sp & 255u) == 0u) { if (xb_ld(&bar[XB_TMO])) break; if (sp > XB_SPIN_CAP) { atomicAdd(&bar[XB_TMO], 1u); break; } }
    }
    nloc = mine > 0u ? mine : 1u; nx = cnt > 0u ? cnt : 1u;
}

__device__ __forceinline__ void xcd_barrier(const XcdBarrier& b) {
    asm volatile("s_waitcnt vmcnt(0)" ::: "memory");
    __syncthreads();
    if (threadIdx.x == 0) {
        unsigned* bar = b.bar;
        __builtin_amdgcn_s_waitcnt(0);
        unsigned nloc = b.st[0], nx = b.st[1];
        if (nloc == 0u) { xcd_barrier_complete(bar, b.x, nloc, nx); b.st[0] = nloc; b.st[1] = nx; }
        const unsigned old = xb_add(&bar[XB_XSUB(b.x)], 1u);
        const unsigned gen = old / nloc;
        if (old + 1u == (gen + 1u) * nloc) {
            __builtin_amdgcn_fence(__ATOMIC_RELEASE, "agent");
            asm volatile("s_waitcnt vmcnt(0)" ::: "memory");
            const unsigned og = xb_add(&bar[XB_TOP], 1u);
            const unsigned tg = og / nx;
            if (og + 1u == (tg + 1u) * nx) xb_add(&bar[XB_TOPGEN], 1u);
            else XB_SPIN(xb_ld(&bar[XB_TOPGEN]) == tg, bar);
            __builtin_amdgcn_fence(__ATOMIC_ACQUIRE, "agent");
            xb_add(&bar[XB_XGEN(b.x)], 1u);
            asm volatile("s_waitcnt vmcnt(0)" ::: "memory");
        } else {
            XB_SPIN(xb_ld(&bar[XB_XGEN(b.x)]) == gen, bar);
            __builtin_amdgcn_fence(__ATOMIC_ACQUIRE, "agent");
            asm volatile("s_waitcnt vmcnt(0)" ::: "memory");
        }
    }
    __syncthreads();
}


#ifndef ORDER_T
#define ORDER_T 0
#endif
namespace pg8 {
constexpr int BM = 256, BK = 64, HALF = 128, HTB = HALF * BK * 2, STAGE_BYTES = 8 * HTB, NXCD = 8, WGM = 4;
__host__ __device__ __forceinline__ int lds_byte(int r, int c) { const int st = (r >> 4) * 2 + (c >> 5), rr = r & 15, cc = c & 31, ob = rr * 64 + cc * 2; return st * 1024 + (ob ^ (((ob >> 9) & 1) << 5)); }
__host__ __device__ __forceinline__ void stage_rc(int b, int& R, int& C) { const int st = b / 1024, sb = b % 1024, swz = sb ^ (((sb >> 9) & 1) << 5); R = (st >> 1) * 16 + swz / 64; C = (st & 1) * 32 + (swz % 64) / 2; }
__host__ __device__ __forceinline__ int perm32(int rho) { const int n = rho >> 4, i = rho & 15; return 8 * (i >> 2) + 4 * n + (i & 3); }
struct Unit { int pm, pn; };
struct Gemm { const bf16_t* A; const bf16_t* Bt; int M, N, K; };
struct StaticOrder {
    int nM, nN, nwg, G, c;
    __device__ void init(int M, int N, int G_, int c_) { nM = M / BM; nN = N / BM; nwg = nM * nN; G = G_; asm volatile("" : "+s"(c_)); c = c_; }
    __device__ bool next(int i, Unit& u) const {
        const long L = (long)i * G + c; if (L >= nwg) return false;
        int wgid = (int)L; { const int q = nwg / NXCD, r = nwg % NXCD, xcd = wgid % NXCD, off = wgid / NXCD; wgid = (xcd < r ? xcd * (q + 1) : r * (q + 1) + (xcd - r) * q) + off; }
#if ORDER_T
        const int nig = WGM * nM, gid = wgid / nig, fn = gid * WGM, gsz = (nN - fn) < WGM ? (nN - fn) : WGM;
        u.pn = fn + ((wgid % nig) % gsz); u.pm = (wgid % nig) / gsz; return true;
#else
        const int nig = WGM * nN, gid = wgid / nig, fm = gid * WGM, gsz = (nM - fm) < WGM ? (nM - fm) : WGM;
        u.pm = fm + ((wgid % nig) % gsz); u.pn = (wgid % nig) / gsz; return true;
#endif
    }
};

template <class Epi>
__device__ __forceinline__ void gemm_phase(LAS unsigned char* lds, const Gemm g, const StaticOrder& S, const Epi& E) {
    int tid = threadIdx.x; asm volatile("" : "+v"(tid));
    const int wid = __builtin_amdgcn_readfirstlane(tid >> 6), lane = tid & 63, wr = wid >> 2, wc = wid & 3, fr = lane & 15, fq = lane >> 4;
    const int K = g.K, nt = K / BK;
    unsigned voffA[2], voffB[2];
#pragma unroll
    for (int i = 0; i < 2; ++i) { int R, C; stage_rc(tid * 16 + i * 8192, R, C); const int Rb = (R & ~31) + perm32(R & 31);
        voffA[i] = (unsigned)(R * K + C) * 2u; voffB[i] = (unsigned)(Rb * K + C) * 2u; }
    const size_t kstep = (size_t)(BK * 2);
    const size_t hstep = (size_t)HALF * K * 2;
    const size_t tstep = 2 * hstep;
    const unsigned ldsw = (unsigned)wid * 1024u;
    const int aoff = lds_byte(wr * 64 + fr, fq * 8), boff = lds_byte(wc * 32 + fr, fq * 8);
#define PG8_SA(b, h) (((b) * 2 + (h)) * HTB)
#define PG8_SB(b, h) ((4 + (b) * 2 + (h)) * HTB)
#define PG8_STAGE(bufoff, gbase, voff) do { _Pragma("unroll") for (int _i = 0; _i < 2; ++_i) \
        __builtin_amdgcn_global_load_lds((const unsigned*)((const char*)(gbase) + (voff)[_i]), (LAS unsigned*)(lds + (bufoff) + ldsw + _i * 8192), 16, 0, 0); } while (0)
#define PG8_LDA(dst, b, h) do { _Pragma("unroll") for (int m = 0; m < 4; ++m) _Pragma("unroll") for (int k = 0; k < 2; ++k) dst[m][k] = *(const LAS bf16x8*)(lds + PG8_SA(b, h) + aoff + m * 2048 + k * 1024); } while (0)
#define PG8_LDB(dst, b, h) do { _Pragma("unroll") for (int n = 0; n < 2; ++n) _Pragma("unroll") for (int k = 0; k < 2; ++k) dst[n][k] = *(const LAS bf16x8*)(lds + PG8_SB(b, h) + boff + n * 2048 + k * 1024); } while (0)
#define PG8_MMA(ai, bj, At, Bt) do { __builtin_amdgcn_s_setprio(1); _Pragma("unroll") for (int m = 0; m < 4; ++m) _Pragma("unroll") for (int n = 0; n < 2; ++n) _Pragma("unroll") for (int k = 0; k < 2; ++k) \
        acc[ai][bj][m][n] = __builtin_amdgcn_mfma_f32_16x16x32_bf16(Bt[n][k], At[m][k], acc[ai][bj][m][n], 0, 0, 0); __builtin_amdgcn_s_setprio(0); } while (0)
#define PG8_WAIT_V(n) asm volatile("s_waitcnt vmcnt(" #n ")" ::: "memory")
#define PG8_WAIT_L(n) asm volatile("s_waitcnt lgkmcnt(" #n ")" ::: "memory")
#define PG8_BAR __builtin_amdgcn_s_barrier()
#define PG8_SCHED __builtin_amdgcn_sched_barrier(0)
    Unit cur, nxt; int ui = 0;
    if (!S.next(0, cur)) return;
    f32x4 acc[2][2][4][2];
#pragma unroll
    for (int a = 0; a < 2; ++a)
#pragma unroll
        for (int b = 0; b < 2; ++b)
#pragma unroll
            for (int m = 0; m < 4; ++m)
#pragma unroll
                for (int n = 0; n < 2; ++n) acc[a][b][m][n] = (f32x4){0.f, 0.f, 0.f, 0.f};
    bf16x8 At[4][2], B0[2][2], B1[2][2];
    const char* cA = (const char*)g.A + (size_t)cur.pm * tstep; const char* cB = (const char*)g.Bt + (size_t)cur.pn * tstep;
    PG8_STAGE(PG8_SB(0, 0), cB, voffB); PG8_STAGE(PG8_SA(0, 0), cA, voffA); PG8_STAGE(PG8_SB(0, 1), cB + hstep, voffB); PG8_STAGE(PG8_SA(0, 1), cA + hstep, voffA);
    if (wr == 1) PG8_BAR;
    PG8_WAIT_V(4); PG8_BAR;
    PG8_STAGE(PG8_SB(1, 0), cB + kstep, voffB); PG8_STAGE(PG8_SA(1, 0), cA + kstep, voffA); PG8_STAGE(PG8_SB(1, 1), cB + hstep + kstep, voffB);
    PG8_WAIT_V(6); PG8_BAR;
    for (;;) {
        const bool has_next = S.next(ui + 1, nxt);
        const char* nA = has_next ? (const char*)g.A + (size_t)nxt.pm * tstep : cA; const char* nB = has_next ? (const char*)g.Bt + (size_t)nxt.pn * tstep : cB;
        for (int t = 0; t < nt; t += 2) {
            const bool last = (t == nt - 2);
            const char* a1 = cA + (size_t)(t + 1) * kstep;
            const char* a2 = last ? nA : cA + (size_t)(t + 2) * kstep; const char* b2 = last ? nB : cB + (size_t)(t + 2) * kstep;
            const char* a3 = a2 + kstep; const char* b3 = b2 + kstep;
            PG8_LDB(B0, 0, 0); PG8_SCHED; PG8_LDA(At, 0, 0); PG8_STAGE(PG8_SA(1, 1), a1 + hstep, voffA);
            PG8_WAIT_L(8); PG8_BAR; PG8_WAIT_L(0); PG8_MMA(0, 0, At, B0); PG8_BAR; PG8_SCHED;
            PG8_LDB(B1, 0, 1); PG8_STAGE(PG8_SB(0, 0), b2, voffB);
            PG8_BAR; PG8_WAIT_L(0); PG8_MMA(0, 1, At, B1); PG8_BAR;
            PG8_LDA(At, 0, 1); PG8_STAGE(PG8_SA(0, 0), a2, voffA);
            PG8_BAR; PG8_WAIT_L(0); PG8_MMA(1, 0, At, B0); PG8_BAR; PG8_SCHED;
            PG8_STAGE(PG8_SB(0, 1), b2 + hstep, voffB);
            PG8_WAIT_V(6); PG8_BAR; PG8_MMA(1, 1, At, B1); PG8_BAR;
            PG8_LDB(B0, 1, 0); PG8_SCHED; PG8_LDA(At, 1, 0); PG8_STAGE(PG8_SA(0, 1), a2 + hstep, voffA);
            PG8_WAIT_L(8); PG8_BAR; PG8_WAIT_L(0); PG8_MMA(0, 0, At, B0); PG8_BAR; PG8_SCHED;
            PG8_LDB(B1, 1, 1); PG8_STAGE(PG8_SB(1, 0), b3, voffB);
            PG8_BAR; PG8_WAIT_L(0); PG8_MMA(0, 1, At, B1); PG8_BAR;
            PG8_LDA(At, 1, 1); PG8_STAGE(PG8_SA(1, 0), a3, voffA);
            PG8_BAR; PG8_WAIT_L(0); PG8_MMA(1, 0, At, B0); PG8_BAR; PG8_SCHED;
            PG8_STAGE(PG8_SB(1, 1), b3 + hstep, voffB);
            PG8_WAIT_V(6); PG8_BAR; PG8_MMA(1, 1, At, B1); PG8_BAR;
        }
        E(acc, cur, wr, wc, fr, fq);
        if (!has_next) break;
#pragma unroll
        for (int a = 0; a < 2; ++a)
#pragma unroll
            for (int b = 0; b < 2; ++b)
#pragma unroll
                for (int m = 0; m < 4; ++m)
#pragma unroll
                    for (int n = 0; n < 2; ++n) acc[a][b][m][n] = (f32x4){0.f, 0.f, 0.f, 0.f};
        cur = nxt; cA = nA; cB = nB; ++ui;
    }
    PG8_WAIT_V(0);
    if (wr == 0) PG8_BAR;
    PG8_BAR;
#undef PG8_SA
#undef PG8_SB
#undef PG8_STAGE
#undef PG8_LDA
#undef PG8_LDB
#undef PG8_MMA
#undef PG8_WAIT_V
#undef PG8_WAIT_L
#undef PG8_BAR
#undef PG8_SCHED
}
}
using pg8::Unit;

#define EPI_HEAD \
        int ln_ = threadIdx.x & 63; asm volatile("" : "+v"(ln_)); const int fr = ln_ & 15, fq = ln_ >> 4; (void)fr_in; (void)fq_in;     \
        const int col0 = u.pn * 256 + wc * 32 + 8 * fq;
#define SB __builtin_amdgcn_sched_barrier(0)
struct SsLoad { f32x4 a, b; };
__device__ __forceinline__ SsLoad ss_load(const float* ssp, int row, int fq) { SsLoad r; const float* p = ssp + (size_t)row * 32 + 8 * fq; r.a = *(const f32x4*)p; r.b = *(const f32x4*)(p + 4); return r; }
__device__ __forceinline__ float ss_sum(const SsLoad& r) { float s = ((r.a[0] + r.a[1]) + (r.a[2] + r.a[3])) + ((r.b[0] + r.b[1]) + (r.b[2] + r.b[3])); s += __shfl_xor(s, 16); s += __shfl_xor(s, 32); return s; }
__device__ __forceinline__ u32x4 pack8(const f32x4& v0, const f32x4& v1) { u32x4 w; w.x = cvt_pk_bf16(v0[0], v0[1]); w.y = cvt_pk_bf16(v0[2], v0[3]); w.z = cvt_pk_bf16(v1[0], v1[1]); w.w = cvt_pk_bf16(v1[2], v1[3]); return w; }
__device__ __forceinline__ float sumsq8(const f32x4& a, const f32x4& b) { return a[0] * a[0] + a[1] * a[1] + a[2] * a[2] + a[3] * a[3] + b[0] * b[0] + b[1] * b[1] + b[2] * b[2] + b[3] * b[3]; }

struct EpiIn {
    bf16_t* Z; const float* ss; const float* cosT; const float* sinT;
    __device__ __forceinline__ void operator()(const f32x4 (&acc)[2][2][4][2], const Unit& u, int wr, int wc, int fr_in, int fq_in) const {
        EPI_HEAD
        const int row0 = u.pm * 256 + wr * 64 + fr;
        const int typ = u.pn >> 2;
        const bool rot = (typ == 4 || typ == 5) && (wc == 0);
        const float sgn = (fq < 2) ? -1.0f : 1.0f;
        SB;
        float rs8[2][4];
        {
            SsLoad sl[2][4];
#pragma unroll
            for (int ai = 0; ai < 2; ++ai)
#pragma unroll
                for (int m = 0; m < 4; ++m) sl[ai][m] = ss_load(ss, row0 + ai * 128 + m * 16, fq);
            SB;
#pragma unroll
            for (int ai = 0; ai < 2; ++ai)
#pragma unroll
                for (int m = 0; m < 4; ++m) rs8[ai][m] = ss_sum(sl[ai][m]);
        }
#pragma unroll
        for (int ai = 0; ai < 2; ++ai)
#pragma unroll
        for (int mh = 0; mh < 2; ++mh) {
            SB;
            float rs[2]; f32x4 c0[2], c1[2], s0[2], s1[2];
#pragma unroll
            for (int mm = 0; mm < 2; ++mm) {
                const int row = row0 + ai * 128 + (2 * mh + mm) * 16;
                rs[mm] = rs8[ai][2 * mh + mm];
                c0[mm] = (f32x4){1.f, 1.f, 1.f, 1.f}; c1[mm] = c0[mm]; s0[mm] = (f32x4){0.f, 0.f, 0.f, 0.f}; s1[mm] = s0[mm];
                if (rot) { const float* cp = cosT + (size_t)row * 16 + 8 * (fq & 1); const float* sp = sinT + (size_t)row * 16 + 8 * (fq & 1);
                    c0[mm] = *(const f32x4*)cp; c1[mm] = *(const f32x4*)(cp + 4); s0[mm] = *(const f32x4*)sp; s1[mm] = *(const f32x4*)(sp + 4); }
            }
            SB;
#pragma unroll
            for (int mm = 0; mm < 2; ++mm) {
                const int m = 2 * mh + mm, row = row0 + ai * 128 + m * 16;
                const float r = rsqrtf(rs[mm] * (1.0f / DM) + EPS);
                bf16_t* rowp = Z + (size_t)row * INC + col0;
#pragma unroll
                for (int bj = 0; bj < 2; ++bj) {
                    f32x4 v0 = acc[ai][bj][m][0] * r, v1 = acc[ai][bj][m][1] * r;
                    if (typ == 0 || typ == 3) {
#pragma unroll
                        for (int j = 0; j < 4; ++j) { v0[j] = siluf_(v0[j]); v1[j] = siluf_(v1[j]); }
                    }
                    if (rot) {
                        f32x4 p0, p1;
#pragma unroll
                        for (int j = 0; j < 4; ++j) { p0[j] = __shfl_xor(v0[j], 32); p1[j] = __shfl_xor(v1[j], 32); }
                        v0 = v0 * c0[mm] + (p0 * s0[mm]) * sgn; v1 = v1 * c1[mm] + (p1 * s1[mm]) * sgn;
                    }
                    if (typ == 4) { v0 = v0 * 0.08838834764831845f; v1 = v1 * 0.08838834764831845f; }
                    *(u32x4*)(rowp + bj * 128) = pack8(v0, v1);
                }
            }
        }
    }
};
__device__ __forceinline__ void unpack8(const u32x4& p, f32x4& a, f32x4& b) { a[0] = bf_lo(p.x); a[1] = bf_hi(p.x); a[2] = bf_lo(p.y); a[3] = bf_hi(p.y); b[0] = bf_lo(p.z); b[1] = bf_hi(p.z); b[2] = bf_lo(p.w); b[3] = bf_hi(p.w); }
struct EpiRes {
    const bf16_t* hin; bf16_t* hb; float* ssacc; int row_off;
    __device__ __forceinline__ void operator()(const f32x4 (&acc)[2][2][4][2], const Unit& u, int wr, int wc, int fr_in, int fq_in) const {
        EPI_HEAD
        const int row0 = row_off + u.pm * 256 + wr * 64 + fr;
#pragma unroll
        for (int ai = 0; ai < 2; ++ai) {
            SB;
            u32x4 hv[4][2];
#pragma unroll
            for (int m = 0; m < 4; ++m)
#pragma unroll
                for (int bj = 0; bj < 2; ++bj) hv[m][bj] = *(const u32x4*)(hin + (size_t)(row0 + ai * 128 + m * 16) * DM + col0 + bj * 128);
            SB;
#pragma unroll
            for (int m = 0; m < 4; ++m) {
                const int row = row0 + ai * 128 + m * 16;
                float sq = 0.f;
#pragma unroll
                for (int bj = 0; bj < 2; ++bj) {
                    f32x4 h0, h1; unpack8(hv[m][bj], h0, h1);
                    h0 = h0 + acc[ai][bj][m][0]; h1 = h1 + acc[ai][bj][m][1];
                    sq += sumsq8(h0, h1);
                    *(u32x4*)(hb + (size_t)row * DM + col0 + bj * 128) = pack8(h0, h1);
                }
                sq += __shfl_xor(sq, 16); sq += __shfl_xor(sq, 32);
                if (fq == 0) ssacc[(size_t)row * 32 + u.pn * 4 + wc] = sq;
            }
        }
    }
};
struct EpiAct {
    bf16_t* act; const float* ss; int row_off;
    __device__ __forceinline__ void operator()(const f32x4 (&acc)[2][2][4][2], const Unit& u, int wr, int wc, int fr_in, int fq_in) const {
        EPI_HEAD
        const int row0 = u.pm * 256 + wr * 64 + fr;
        SB;
        float rs[2][4];
        {
            SsLoad sl[2][4];
#pragma unroll
            for (int ai = 0; ai < 2; ++ai)
#pragma unroll
                for (int m = 0; m < 4; ++m) sl[ai][m] = ss_load(ss, row_off + row0 + ai * 128 + m * 16, fq);
            SB;
#pragma unroll
            for (int ai = 0; ai < 2; ++ai)
#pragma unroll
                for (int m = 0; m < 4; ++m) rs[ai][m] = ss_sum(sl[ai][m]);
        }
        SB;
#pragma unroll
        for (int ai = 0; ai < 2; ++ai)
#pragma unroll
            for (int m = 0; m < 4; ++m) {
                const int row = row0 + ai * 128 + m * 16;
                const float r = rsqrtf(rs[ai][m] * (1.0f / DM) + EPS);
#pragma unroll
                for (int bj = 0; bj < 2; ++bj) {
                    f32x4 v0 = acc[ai][bj][m][0] * r, v1 = acc[ai][bj][m][1] * r;
#pragma unroll
                    for (int j = 0; j < 4; ++j) { const float a = fmaxf(v0[j], 0.f), b = fmaxf(v1[j], 0.f); v0[j] = a * a; v1[j] = b * b; }
                    *(u32x4*)(act + (size_t)row * DFF + col0 + bj * 128) = pack8(v0, v1);
                }
            }
    }
};
struct EpiPP {
    bf16_t* O;
    __device__ __forceinline__ void operator()(const f32x4 (&acc)[2][2][4][2], const Unit& u, int wr, int wc, int fr_in, int fq_in) const {
        EPI_HEAD
        const int row0 = u.pm * 256 + wr * 64 + fr;
#pragma unroll
        for (int ai = 0; ai < 2; ++ai)
#pragma unroll
            for (int m = 0; m < 4; ++m) {
                const int row = row0 + ai * 128 + m * 16;
#pragma unroll
                for (int bj = 0; bj < 2; ++bj) *(u32x4*)(O + (size_t)row * DM + col0 + bj * 128) = pack8(acc[ai][bj][m][0], acc[ai][bj][m][1]);
            }
    }
};
struct EpiPle {
    const bf16_t* hin; bf16_t* hb; float* fout; const bf16_t* PP; const float* ss; float* ssacc;
    __device__ __forceinline__ void operator()(const f32x4 (&acc)[2][2][4][2], const Unit& u, int wr, int wc, int fr_in, int fq_in) const {
        EPI_HEAD
        const int row0 = u.pm * 256 + wr * 64 + fr;
#pragma unroll
        for (int ai = 0; ai < 2; ++ai)
#pragma unroll
        for (int mh = 0; mh < 2; ++mh) {
            SB;
            u32x4 hv[2][2], pp[2][2]; float rs[2]; SsLoad sl[2];
#pragma unroll
            for (int mm = 0; mm < 2; ++mm) {
                const int row = row0 + ai * 128 + (2 * mh + mm) * 16;
                sl[mm] = ss_load(ss, row, fq);
#pragma unroll
                for (int bj = 0; bj < 2; ++bj) { const size_t o = (size_t)row * DM + col0 + bj * 128; hv[mm][bj] = *(const u32x4*)(hin + o); pp[mm][bj] = *(const u32x4*)(PP + o); }
            }
            SB;
            rs[0] = ss_sum(sl[0]); rs[1] = ss_sum(sl[1]);
#pragma unroll
            for (int mm = 0; mm < 2; ++mm) {
                const int m = 2 * mh + mm, row = row0 + ai * 128 + m * 16;
                const float r = rsqrtf(rs[mm] * (1.0f / DM) + EPS);
                float sq = 0.f;
#pragma unroll
                for (int bj = 0; bj < 2; ++bj) {
                    const size_t o = (size_t)row * DM + col0 + bj * 128;
                    f32x4 h0, h1, p0, p1; unpack8(hv[mm][bj], h0, h1); unpack8(pp[mm][bj], p0, p1);
                    f32x4 g0 = acc[ai][bj][m][0] * r, g1 = acc[ai][bj][m][1] * r;
#pragma unroll
                    for (int j = 0; j < 4; ++j) { g0[j] = sigmoidf_(g0[j]); g1[j] = sigmoidf_(g1[j]); }
                    h0 = h0 + p0 * g0; h1 = h1 + p1 * g1;
                    sq += sumsq8(h0, h1);
                    if (fout) { *(f32x4*)(fout + o) = h0; *(f32x4*)(fout + o + 4) = h1; }
                    else *(u32x4*)(hb + o) = pack8(h0, h1);
                }
                sq += __shfl_xor(sq, 16); sq += __shfl_xor(sq, 32);
                if (fq == 0) ssacc[(size_t)row * 32 + u.pn * 4 + wc] = sq;
            }
        }
    }
};

__device__ void transpose_job(LAS unsigned char* lds, const float* src, const float* gain, bf16_t* dst, int K, int N) {
    LAS float* tile = (LAS float*)lds;
    int tid = threadIdx.x; asm volatile("" : "+v"(tid));
    const int tn = N >> 6, ntile = (K >> 6) * tn;
    const int kr0 = tid >> 4, c4 = (tid & 15) * 4;
    f32x4 v[2]; float g[2];
    auto issue = [&](int t) {
        const int k0 = (t / tn) << 6, n0 = (t % tn) << 6;
#pragma unroll
        for (int i = 0; i < 2; ++i) { v[i] = *(const f32x4*)(src + (size_t)(k0 + kr0 + 32 * i) * N + n0 + c4); g[i] = gain ? gain[k0 + kr0 + 32 * i] : 1.0f; }
    };
    int t = blockIdx.x;
    if (t < ntile) issue(t);
    for (; t < ntile; t += gridDim.x) {
        const int k0 = (t / tn) << 6, n0 = (t % tn) << 6;
#pragma unroll
        for (int i = 0; i < 2; ++i) { const int kr = kr0 + 32 * i;
            tile[kr * 65 + c4 + 0] = v[i][0] * g[i]; tile[kr * 65 + c4 + 1] = v[i][1] * g[i]; tile[kr * 65 + c4 + 2] = v[i][2] * g[i]; tile[kr * 65 + c4 + 3] = v[i][3] * g[i]; }
        __syncthreads();
        if (t + (int)gridDim.x < ntile) issue(t + gridDim.x);
        {
            const int n = tid >> 3, kc = (tid & 7) * 8;
            float o[8];
#pragma unroll
            for (int j = 0; j < 8; ++j) o[j] = tile[(kc + j) * 65 + n];
            u32x4 w; w.x = cvt_pk_bf16(o[0], o[1]); w.y = cvt_pk_bf16(o[2], o[3]); w.z = cvt_pk_bf16(o[4], o[5]); w.w = cvt_pk_bf16(o[6], o[7]);
            *(u32x4*)(dst + (size_t)(n0 + n) * K + k0 + kc) = w;
        }
        __syncthreads();
    }
}

__device__ void prep_phase(const Params& P, LAS unsigned char* lds) {
    unsigned char* ws = P.ws;
    int tid = threadIdx.x; asm volatile("" : "+v"(tid));
    const int lane = tid & 63, w = tid >> 6;
    for (int l = 0; l < 2; ++l) {
        unsigned char* wl = ws + OFF_W + (size_t)l * SZ_WL;
        transpose_job(lds, P.w_in + (size_t)l * DM * INC, P.norm1 + l * DM, (bf16_t*)(wl + WO_IN), DM, INC);
        transpose_job(lds, P.w_out + (size_t)l * DM * DM, nullptr, (bf16_t*)(wl + WO_OUT), DM, DM);
        transpose_job(lds, P.w1 + (size_t)l * DM * DFF, P.norm2 + l * DM, (bf16_t*)(wl + WO_1), DM, DFF);
        transpose_job(lds, P.w2 + (size_t)l * DFF * DM, nullptr, (bf16_t*)(wl + WO_2), DFF, DM);
        transpose_job(lds, P.w_pg + (size_t)l * DM * DM, P.ple_norm + l * DM, (bf16_t*)(wl + WO_PG), DM, DM);
        transpose_job(lds, P.w_pp + (size_t)l * PLE * DM, nullptr, (bf16_t*)(wl + WO_PP), PLE, DM);
    }
    {
        bf16_t* hb1 = (bf16_t*)(ws + OFF_MIX); float* ss0 = (float*)(ws + OFF_SSP);
        for (int row = blockIdx.x * 8 + w; row < NTOK; row += gridDim.x * 8) {
            const float* xr = P.x + (size_t)row * DM; float sq = 0.f;
#pragma unroll
            for (int i = 0; i < 8; ++i) {
                const f32x4 v = *(const f32x4*)(xr + i * 256 + lane * 4);
                sq += v[0] * v[0] + v[1] * v[1] + v[2] * v[2] + v[3] * v[3];
                u32x2 o; o.x = cvt_pk_bf16(v[0], v[1]); o.y = cvt_pk_bf16(v[2], v[3]);
                *(u32x2*)(hb1 + (size_t)row * DM + i * 256 + lane * 4) = o;
            }
            sq = wave_sum(sq);
            if (lane < 32) ss0[(size_t)row * 32 + lane] = (lane == 0) ? sq : 0.f;
        }
    }
    const size_t gt = (size_t)blockIdx.x * 512 + tid, gn = (size_t)gridDim.x * 512;
    {
        bf16_t* pb = (bf16_t*)(ws + OFF_PB); const size_t n4 = 2ull * NTOK * PLE / 4;
        for (size_t i = gt; i < n4; i += gn) { const f32x4 v = *(const f32x4*)(P.p + i * 4); u32x2 o; o.x = cvt_pk_bf16(v[0], v[1]); o.y = cvt_pk_bf16(v[2], v[3]); *(u32x2*)(pb + i * 4) = o; }
    }
    {
        float* cosT = (float*)(ws + OFF_CS); float* sinT = cosT + (size_t)NTOK * 16;
        for (size_t i = gt; i < (size_t)NTOK * 16; i += gn) {
            const int tok = (int)(i >> 4), fi = (int)(i & 15);
            const float inv = 1.0f / powf(500000.0f, (float)fi * (1.0f / 16.0f));
            const float ang = (float)P.pos[tok] * inv;
            float s, c; sincosf(ang, &s, &c);
            cosT[i] = c; sinT[i] = s;
        }
    }
    if (blockIdx.x == 0 && tid < 2) ((unsigned*)(ws + OFF_CTR))[tid] = 0u;
}

constexpr int HQ_OFF = 0, HQ_ROW = 272;
constexpr int HK_OFF = HQ_OFF + 64 * HQ_ROW;
constexpr int HKT_OFF = HK_OFF + 64 * HQ_ROW, HT_ROW = 144;
constexpr int HVT_OFF = HKT_OFF + 128 * HT_ROW;
constexpr int HP_OFF = HVT_OFF + 128 * HT_ROW;
constexpr int HTOT_OFF = HP_OFF + 64 * HT_ROW;
constexpr int HEM_OFF = HTOT_OFF + 2048, HEB_OFF = HEM_OFF + 512, HEBM_OFF = HEB_OFF + 512, H_END = HEBM_OFF + 512;
static_assert(H_END <= LDS_BYTES, "hgrn LDS");
template <bool full>
__device__ void hgrn_seq(const Params& P, LAS unsigned char* lds, int seq, int seg, int layer, const bf16_t* z, bf16_t* mixb, float* Ust, float* Dst) {
    int tid = threadIdx.x; asm volatile("" : "+v"(tid));
    const int lane = tid & 63, w = tid >> 6, r16 = lane & 15, qq = lane >> 4;
    const int b = seq >> 3, hh = seq & 7;
    const int k = tid & 127, tq = tid >> 7;
    const float lbk = (layer == 0) ? 0.f : 1.0f / (1.0f + expf(P.lb[hh * 128 + k] - P.lb[1024 + hh * 128 + k]));
    const float omlb = 1.0f - lbk;
    const bf16_t* zb = z + (size_t)b * SEQ * INC + hh * 128 + k;
    LAS float* tot = (LAS float*)(lds + HTOT_OFF); LAS float* EM = (LAS float*)(lds + HEM_OFF); LAS float* EB = (LAS float*)(lds + HEB_OFF); LAS float* EBM = (LAS float*)(lds + HEBM_OFF);
    bf16_t pq[16], px[16], pv[16];
    auto issue = [&](int c) {
#pragma unroll
        for (int i = 0; i < 16; ++i) { const bf16_t* rp = zb + (size_t)(c * 64 + tq * 16 + i) * INC; if (full) pq[i] = rp[0]; else pq[i] = 0; px[i] = rp[1024]; pv[i] = rp[2048]; }
    };
    const int c_lo = seg * 16, c_hi = c_lo + 16;
    issue(c_lo);
    f32x4 S[8];
#pragma unroll
    for (int i = 0; i < 8; ++i) S[i] = (f32x4){0.f, 0.f, 0.f, 0.f};
    if (full) {
        for (int j = 0; j < seg; ++j) {
            const float* Uj = Ust + ((size_t)(seq * 8 + j) << 14); const float* Dj = Dst + (size_t)(seq * 8 + j) * 128;
#pragma unroll
            for (int kt = 0; kt < 8; ++kt) {
                const f32x4 dj = *(const f32x4*)(Dj + 16 * kt + 4 * qq);
#pragma unroll
                for (int j4 = 0; j4 < 4; ++j4) S[kt][j4] = __builtin_amdgcn_exp2f(dj[j4]) * S[kt][j4] + Uj[(size_t)(16 * kt + 4 * qq + j4) * 128 + 16 * w + r16];
            }
        }
    }
    float bsum = 0.f;
    __syncthreads();
    for (int c = c_lo; c < c_hi; ++c) {
        float cs[16], kkv[16], qv[16];
        {
            float run = 0.f;
#pragma unroll
            for (int i = 0; i < 16; ++i) {
                const float xs = fmaxf(bf2f(px[i]) * 1.4426950408889634f, -100.0f);
                const float e = __builtin_amdgcn_exp2f(-xs);
                const float sg = __builtin_amdgcn_rcpf(1.0f + e);
                const float f = lbk + omlb * sg;
                kkv[i] = omlb * (e * sg);
                run += __builtin_amdgcn_logf(f);
                cs[i] = run; qv[i] = bf2f(pq[i]);
            }
            tot[tq * 128 + k] = run;
        }
        {
            u32x4 v0, v1;
            v0.x = (unsigned)pv[0] | ((unsigned)pv[1] << 16); v0.y = (unsigned)pv[2] | ((unsigned)pv[3] << 16); v0.z = (unsigned)pv[4] | ((unsigned)pv[5] << 16); v0.w = (unsigned)pv[6] | ((unsigned)pv[7] << 16);
            v1.x = (unsigned)pv[8] | ((unsigned)pv[9] << 16); v1.y = (unsigned)pv[10] | ((unsigned)pv[11] << 16); v1.z = (unsigned)pv[12] | ((unsigned)pv[13] << 16); v1.w = (unsigned)pv[14] | ((unsigned)pv[15] << 16);
            *(LAS u32x4*)(lds + HVT_OFF + k * HT_ROW + tq * 32) = v0; *(LAS u32x4*)(lds + HVT_OFF + k * HT_ROW + tq * 32 + 16) = v1;
        }
        if (c + 1 < c_hi) issue(c + 1);
        __syncthreads();
        {
            const float t0 = tot[k], t1 = tot[128 + k], t2 = tot[256 + k], t3 = tot[384 + k];
            const float m2 = t0 + t1, b63 = (t0 + t1) + (t2 + t3);
            const float off = (tq == 0) ? 0.f : (tq == 1 ? t0 : (tq == 2 ? m2 : m2 + t2));
            unsigned kt[8];
#pragma unroll
            for (int i = 0; i < 16; i += 2) {
                const float d0 = off + cs[i] - m2, d1 = off + cs[i + 1] - m2;
                const float q0 = qv[i] * __builtin_amdgcn_exp2f(d0), q1 = qv[i + 1] * __builtin_amdgcn_exp2f(d1);
                const float k0 = kkv[i] * __builtin_amdgcn_exp2f(-d0), k1 = kkv[i + 1] * __builtin_amdgcn_exp2f(-d1);
                const unsigned qp = cvt_pk_bf16(q0, q1), kp = cvt_pk_bf16(k0, k1);
                if (full) {
                    *(LAS bf16_t*)(lds + HQ_OFF + (tq * 16 + i) * HQ_ROW + k * 2) = (bf16_t)(qp & 0xffffu);
                    *(LAS bf16_t*)(lds + HQ_OFF + (tq * 16 + i + 1) * HQ_ROW + k * 2) = (bf16_t)(qp >> 16);
                    *(LAS bf16_t*)(lds + HK_OFF + (tq * 16 + i) * HQ_ROW + k * 2) = (bf16_t)(kp & 0xffffu);
                    *(LAS bf16_t*)(lds + HK_OFF + (tq * 16 + i + 1) * HQ_ROW + k * 2) = (bf16_t)(kp >> 16);
                }
                kt[i >> 1] = kp;
            }
            u32x4 a0, a1; a0.x = kt[0]; a0.y = kt[1]; a0.z = kt[2]; a0.w = kt[3]; a1.x = kt[4]; a1.y = kt[5]; a1.z = kt[6]; a1.w = kt[7];
            *(LAS u32x4*)(lds + HKT_OFF + k * HT_ROW + tq * 32) = a0; *(LAS u32x4*)(lds + HKT_OFF + k * HT_ROW + tq * 32 + 16) = a1;
            if (tq == 0) { EM[k] = __builtin_amdgcn_exp2f(m2); EB[k] = __builtin_amdgcn_exp2f(b63); EBM[k] = __builtin_amdgcn_exp2f(b63 - m2); bsum += b63; }
        }
        __syncthreads();
        if (full) {
            const int st = w >> 1;
#pragma unroll
            for (int u = 0; u < 2; ++u) {
                const int tt = 2 * (w & 1) + u;
                f32x4 d = (f32x4){0.f, 0.f, 0.f, 0.f};
                if (tt >= st) {
#pragma unroll
                    for (int ks = 0; ks < 4; ++ks) {
                        const bf16x8 a = *(const LAS bf16x8*)(lds + HK_OFF + (16 * st + r16) * HQ_ROW + (32 * ks + 8 * qq) * 2);
                        const bf16x8 bq = *(const LAS bf16x8*)(lds + HQ_OFF + (16 * tt + r16) * HQ_ROW + (32 * ks + 8 * qq) * 2);
                        d = __builtin_amdgcn_mfma_f32_16x16x32_bf16(a, bq, d, 0, 0, 0);
                    }
                }
                const int t = 16 * tt + r16, s0 = 16 * st + 4 * qq;
                u32x2 pw; pw.x = cvt_pk_bf16(s0 <= t ? d[0] : 0.f, s0 + 1 <= t ? d[1] : 0.f); pw.y = cvt_pk_bf16(s0 + 2 <= t ? d[2] : 0.f, s0 + 3 <= t ? d[3] : 0.f);
                *(LAS u32x2*)(lds + HP_OFF + t * HT_ROW + s0 * 2) = pw;
            }
            __syncthreads();
        }
        {
            bf16x8 bV[2];
#pragma unroll
            for (int ss = 0; ss < 2; ++ss) bV[ss] = *(const LAS bf16x8*)(lds + HVT_OFF + (16 * w + r16) * HT_ROW + (32 * ss + 8 * qq) * 2);
            if (full) {
            f32x4 O[4];
#pragma unroll
            for (int tt = 0; tt < 4; ++tt) {
                O[tt] = (f32x4){0.f, 0.f, 0.f, 0.f};
#pragma unroll
                for (int ss = 0; ss < 2; ++ss) {
                    const bf16x8 aP = *(const LAS bf16x8*)(lds + HP_OFF + (16 * tt + r16) * HT_ROW + (32 * ss + 8 * qq) * 2);
                    O[tt] = __builtin_amdgcn_mfma_f32_16x16x32_bf16(aP, bV[ss], O[tt], 0, 0, 0);
                }
            }
#pragma unroll
            for (int ks = 0; ks < 4; ++ks) {
                const f32x4 ea = *(const LAS f32x4*)(EM + 32 * ks + 4 * qq), eb = *(const LAS f32x4*)(EM + 32 * ks + 16 + 4 * qq);
                const f32x4 sa = S[2 * ks] * ea, sb = S[2 * ks + 1] * eb;
                u32x4 bw; bw.x = cvt_pk_bf16(sa[0], sa[1]); bw.y = cvt_pk_bf16(sa[2], sa[3]); bw.z = cvt_pk_bf16(sb[0], sb[1]); bw.w = cvt_pk_bf16(sb[2], sb[3]);
                const bf16x8 bS = __builtin_bit_cast(bf16x8, bw);
#pragma unroll
                for (int tt = 0; tt < 4; ++tt) {
                    const LAS unsigned char* ap = lds + HQ_OFF + (16 * tt + r16) * HQ_ROW + (32 * ks + 4 * qq) * 2;
                    const u32x2 q0 = *(const LAS u32x2*)ap, q1 = *(const LAS u32x2*)(ap + 32);
                    u32x4 aw; aw.x = q0.x; aw.y = q0.y; aw.z = q1.x; aw.w = q1.y;
                    O[tt] = __builtin_amdgcn_mfma_f32_16x16x32_bf16(__builtin_bit_cast(bf16x8, aw), bS, O[tt], 0, 0, 0);
                }
            }
            bf16_t* op = mixb + (size_t)(b * SEQ + c * 64) * DM + hh * 128 + 16 * w + r16;
#pragma unroll
            for (int tt = 0; tt < 4; ++tt)
#pragma unroll
                for (int j = 0; j < 4; ++j) op[(size_t)(16 * tt + 4 * qq + j) * DM] = f2bf(O[tt][j]);
            }
#pragma unroll
            for (int kt = 0; kt < 8; ++kt) {
                f32x4 W = (f32x4){0.f, 0.f, 0.f, 0.f};
#pragma unroll
                for (int ss = 0; ss < 2; ++ss) {
                    const bf16x8 aK = *(const LAS bf16x8*)(lds + HKT_OFF + (16 * kt + r16) * HT_ROW + (32 * ss + 8 * qq) * 2);
                    W = __builtin_amdgcn_mfma_f32_16x16x32_bf16(aK, bV[ss], W, 0, 0, 0);
                }
                const f32x4 e63 = *(const LAS f32x4*)(EB + 16 * kt + 4 * qq), ebm = *(const LAS f32x4*)(EBM + 16 * kt + 4 * qq);
                S[kt] = e63 * S[kt] + ebm * W;
            }
        }
        __syncthreads();
    }
    if (!full) {
        float* Uo = Ust + ((size_t)(seq * 8 + seg) << 14);
#pragma unroll
        for (int kt = 0; kt < 8; ++kt)
#pragma unroll
            for (int j4 = 0; j4 < 4; ++j4) Uo[(size_t)(16 * kt + 4 * qq + j4) * 128 + 16 * w + r16] = S[kt][j4];
        if (tq == 0) Dst[(size_t)(seq * 8 + seg) * 128 + k] = bsum;
    }
}

constexpr int KROW = 272, VROW = 288, VT_OFF = 256 * KROW;
static_assert(VT_OFF + 256 * VROW <= 143360, "attention LDS");
typedef short s16x4 __attribute__((ext_vector_type(4)));
__device__ void attn_run(LAS unsigned char* lds, int run, const bf16_t* z, bf16_t* mixb, bf16_t* part1, bf16_t* part2, f32x2* ml) {
    int tid = threadIdx.x; asm volatile("" : "+v"(tid));
    const int lane = tid & 63, w = tid >> 6, r16 = lane & 15, qq = lane >> 4;
    const int item0 = 4 * run;
    const int bh = item0 / 192, rem = item0 - bh * 192, g = rem >> 6, blk = rem & 63, b = bh >> 3, hh = bh & 7;
    const int lg = 2 * g, d = 1 << lg, nbl = 6 - lg;
    const int res = blk >> nbl, n0 = blk & ((1 << nbl) - 1);
    const bf16_t* zb = z + (size_t)b * SEQ * INC;
    const int qi = 16 * w + r16;
    const int srow = tid >> 4, scc = tid & 15;
    const bf16_t* kbase = zb + (size_t)res * INC + 5120 + hh * 128 + scc * 8;
    const bf16_t* qbase = z + ((size_t)b * SEQ + res) * INC + 4096 + hh * 128 + 8 * qq;
    __syncthreads();
    {
#pragma unroll
        for (int i = 0; i < 4; ++i) {
            const int row = srow + 32 * i, s = 128 * (n0 - 1) + row;
            u32x4 kv = (u32x4){0u, 0u, 0u, 0u}, vv = kv;
            if (s >= 0) { const bf16_t* rp = kbase + (size_t)s * d * INC; kv = *(const u32x4*)rp; vv = *(const u32x4*)(rp + 1024); }
            *(LAS u32x4*)(lds + row * KROW + scc * 16) = kv; *(LAS u32x4*)(lds + VT_OFF + row * VROW + scc * 16) = vv;
        }
    }
    u32x4 kc[4], vc[4]; bf16x8 qn[4];
#pragma unroll
    for (int i = 0; i < 4; ++i) { const bf16_t* rp = kbase + (size_t)(128 * n0 + srow + 32 * i) * d * INC; kc[i] = *(const u32x4*)rp; vc[i] = *(const u32x4*)(rp + 1024); }
#pragma unroll
    for (int ks = 0; ks < 4; ++ks) qn[ks] = *(const bf16x8*)(qbase + (size_t)(128 * n0 + qi) * d * INC + 32 * ks);
#pragma unroll 1
    for (int f = 0; f < 4; ++f) {
    const int n = n0 + f, flip = f & 1;
    {
        const int rb = flip ? 0 : 128;
#pragma unroll
        for (int i = 0; i < 4; ++i) { const int row = rb + srow + 32 * i; *(LAS u32x4*)(lds + row * KROW + scc * 16) = kc[i]; *(LAS u32x4*)(lds + VT_OFF + row * VROW + scc * 16) = vc[i]; }
    }
    bf16x8 qf[4];
#pragma unroll
    for (int ks = 0; ks < 4; ++ks) qf[ks] = qn[ks];
    const int tokq = b * SEQ + (128 * n + qi) * d + res;
    __syncthreads();
    if (f < 3) {
#pragma unroll
        for (int i = 0; i < 4; ++i) { const bf16_t* rp = kbase + (size_t)(128 * (n + 1) + srow + 32 * i) * d * INC; kc[i] = *(const u32x4*)rp; vc[i] = *(const u32x4*)(rp + 1024); }
#pragma unroll
        for (int ks = 0; ks < 4; ++ks) qn[ks] = *(const bf16x8*)(qbase + (size_t)(128 * (n + 1) + qi) * d * INC + 32 * ks);
    }
    const int w0 = w < 6 ? w : 6;
    const int fx = flip ? 8 : 0;
    f32x4 s[10];
    {
        bf16x8 ka[2][2][4];
#pragma unroll
        for (int u = 0; u < 2; ++u)
#pragma unroll
            for (int ks = 0; ks < 4; ++ks) ka[0][u][ks] = *(const LAS bf16x8*)(lds + (16 * ((w0 + u) ^ fx) + r16) * KROW + (32 * ks + 8 * qq) * 2);
#pragma unroll
        for (int tp = 0; tp < 5; ++tp) {
            if (tp < 4) {
#pragma unroll
                for (int u = 0; u < 2; ++u)
#pragma unroll
                    for (int ks = 0; ks < 4; ++ks) ka[(tp + 1) & 1][u][ks] = *(const LAS bf16x8*)(lds + (16 * ((w0 + 2 * tp + 2 + u) ^ fx) + r16) * KROW + (32 * ks + 8 * qq) * 2);
            }
            SB;
#pragma unroll
            for (int u = 0; u < 2; ++u) {
                s[2 * tp + u] = (f32x4){0.f, 0.f, 0.f, 0.f};
#pragma unroll
                for (int ks = 0; ks < 4; ++ks) s[2 * tp + u] = __builtin_amdgcn_mfma_f32_16x16x32_bf16(ka[tp & 1][u][ks], qf[ks], s[2 * tp + u], 0, 0, 0);
            }
            SB;
        }
    }
    float mx = -3.0e38f;
#pragma unroll
    for (int t = 0; t < 10; ++t)
#pragma unroll
        for (int j = 0; j < 4; ++j) {
            const int kj = 16 * (w0 + t) + 4 * qq + j;
            const bool valid = (kj >= qi) && (kj <= qi + 128) && (n > 0 || kj >= 128);
            s[t][j] = valid ? s[t][j] : -3.0e38f;
            mx = fmaxf(mx, s[t][j]);
        }
    mx = fmaxf(mx, __shfl_xor(mx, 16)); mx = fmaxf(mx, __shfl_xor(mx, 32));
    float l = 0.f;
#pragma unroll
    for (int t = 0; t < 10; ++t)
#pragma unroll
        for (int j = 0; j < 4; ++j) { const float p = __expf(s[t][j] - mx); l += p; s[t][j] = p; }
    l += __shfl_xor(l, 16); l += __shfl_xor(l, 32);
    f32x4 o[8];
#pragma unroll
    for (int nd = 0; nd < 8; ++nd) o[nd] = (f32x4){0.f, 0.f, 0.f, 0.f};
    {
        s16x4 va[2][8][2];
        LAS unsigned char* ap0 = lds + VT_OFF + (4 * qq + (r16 >> 2)) * VROW + (4 * (r16 & 3)) * 2;
#pragma unroll
        for (int nd = 0; nd < 8; ++nd) { va[0][nd][0] = __builtin_amdgcn_ds_read_tr16_b64_v4i16((LAS s16x4*)(ap0 + 16 * ((w0) ^ fx) * VROW + 32 * nd)); va[0][nd][1] = __builtin_amdgcn_ds_read_tr16_b64_v4i16((LAS s16x4*)(ap0 + 16 * ((w0 + 1) ^ fx) * VROW + 32 * nd)); }
#pragma unroll
        for (int i = 0; i < 5; ++i) {
            if (i < 4) {
#pragma unroll
                for (int nd = 0; nd < 8; ++nd) { va[(i + 1) & 1][nd][0] = __builtin_amdgcn_ds_read_tr16_b64_v4i16((LAS s16x4*)(ap0 + 16 * ((w0 + 2 * i + 2) ^ fx) * VROW + 32 * nd)); va[(i + 1) & 1][nd][1] = __builtin_amdgcn_ds_read_tr16_b64_v4i16((LAS s16x4*)(ap0 + 16 * ((w0 + 2 * i + 3) ^ fx) * VROW + 32 * nd)); }
            }
            u32x4 pw; pw.x = cvt_pk_bf16(s[2 * i][0], s[2 * i][1]); pw.y = cvt_pk_bf16(s[2 * i][2], s[2 * i][3]); pw.z = cvt_pk_bf16(s[2 * i + 1][0], s[2 * i + 1][1]); pw.w = cvt_pk_bf16(s[2 * i + 1][2], s[2 * i + 1][3]);
            const bf16x8 pb = __builtin_bit_cast(bf16x8, pw);
            SB;
#pragma unroll
            for (int nd = 0; nd < 8; ++nd) {
                const s16x4 a0 = va[i & 1][nd][0], a1 = va[i & 1][nd][1];
                bf16x8 aw; aw[0] = a0[0]; aw[1] = a0[1]; aw[2] = a0[2]; aw[3] = a0[3]; aw[4] = a1[0]; aw[5] = a1[1]; aw[6] = a1[2]; aw[7] = a1[3];
                o[nd] = __builtin_amdgcn_mfma_f32_16x16x32_bf16(aw, pb, o[nd], 0, 0, 0);
            }
            SB;
        }
    }
    const float inv = 1.0f / l;
    bf16_t* dst = (g == 0) ? (mixb + (size_t)tokq * DM + 1024 + hh * 128) : ((g == 1 ? part1 : part2) + (size_t)tokq * 1024 + hh * 128);
#pragma unroll
    for (int nd = 0; nd < 8; ++nd) {
        u32x2 ow; ow.x = cvt_pk_bf16(o[nd][0] * inv, o[nd][1] * inv); ow.y = cvt_pk_bf16(o[nd][2] * inv, o[nd][3] * inv);
        *(u32x2*)(dst + 16 * nd + 4 * qq) = ow;
    }
    if (qq == 0) ml[(size_t)g * NTOK * 8 + (size_t)tokq * 8 + hh] = (f32x2){mx, l};
    __syncthreads();
    }
}

__device__ void mixfin_phase(const Params& P, int layer, const bf16_t* z, bf16_t* mixb, const bf16_t* part1, const bf16_t* part2, const f32x2* ml) {
    int tid = threadIdx.x; asm volatile("" : "+v"(tid));
    const int lane = tid & 63, w = tid >> 6, hl = lane >> 4, dl = (lane & 15) * 8;
    float gh[8], ga[8];
#pragma unroll
    for (int j = 0; j < 8; ++j) { gh[j] = P.hgrn_norm[layer * 128 + dl + j]; ga[j] = P.attn_norm[layer * 128 + dl + j]; }
    for (int tok = blockIdx.x * 8 + w; tok < NTOK; tok += gridDim.x * 8) {
        bf16_t* mrow = mixb + (size_t)tok * DM;
        u32x4 oh[2], zg[2], a0[2], a1[2], a2[2]; f32x2 m0[2], m1[2], m2[2];
#pragma unroll
        for (int q = 0; q < 2; ++q) {
            const int hd = 4 * q + hl;
            oh[q] = *(const u32x4*)(mrow + hd * 128 + dl);
            zg[q] = *(const u32x4*)(z + (size_t)tok * INC + 3072 + hd * 128 + dl);
            a0[q] = *(const u32x4*)(mrow + 1024 + hd * 128 + dl);
            a1[q] = *(const u32x4*)(part1 + (size_t)tok * 1024 + hd * 128 + dl);
            a2[q] = *(const u32x4*)(part2 + (size_t)tok * 1024 + hd * 128 + dl);
            m0[q] = ml[(size_t)tok * 8 + hd]; m1[q] = ml[(size_t)NTOK * 8 + (size_t)tok * 8 + hd]; m2[q] = ml[(size_t)2 * NTOK * 8 + (size_t)tok * 8 + hd];
        }
#pragma unroll
        for (int q = 0; q < 2; ++q) {
            const int hd = 4 * q + hl;
            {
                const unsigned ou[4] = {oh[q].x, oh[q].y, oh[q].z, oh[q].w}, zu[4] = {zg[q].x, zg[q].y, zg[q].z, zg[q].w};
                float v[8]; float sq = 0.f;
#pragma unroll
                for (int j = 0; j < 4; ++j) { v[2 * j] = bf_lo(ou[j]); v[2 * j + 1] = bf_hi(ou[j]); sq += v[2 * j] * v[2 * j] + v[2 * j + 1] * v[2 * j + 1]; }
                sq += __shfl_xor(sq, 8); sq += __shfl_xor(sq, 4); sq += __shfl_xor(sq, 2); sq += __shfl_xor(sq, 1);
                const float rs = rsqrtf(sq * (1.0f / 128.0f) + EPS);
                u32x4 o;
                o.x = cvt_pk_bf16(v[0] * rs * gh[0] * bf_lo(zu[0]), v[1] * rs * gh[1] * bf_hi(zu[0])); o.y = cvt_pk_bf16(v[2] * rs * gh[2] * bf_lo(zu[1]), v[3] * rs * gh[3] * bf_hi(zu[1]));
                o.z = cvt_pk_bf16(v[4] * rs * gh[4] * bf_lo(zu[2]), v[5] * rs * gh[5] * bf_hi(zu[2])); o.w = cvt_pk_bf16(v[6] * rs * gh[6] * bf_lo(zu[3]), v[7] * rs * gh[7] * bf_hi(zu[3]));
                *(u32x4*)(mrow + hd * 128 + dl) = o;
            }
            {
                const float mm = fmaxf(m0[q].x, fmaxf(m1[q].x, m2[q].x));
                const float w0 = m0[q].y * __expf(m0[q].x - mm), w1 = m1[q].y * __expf(m1[q].x - mm), w2 = m2[q].y * __expf(m2[q].x - mm);
                const float iw = 1.0f / (w0 + w1 + w2);
                const unsigned u0[4] = {a0[q].x, a0[q].y, a0[q].z, a0[q].w}, u1[4] = {a1[q].x, a1[q].y, a1[q].z, a1[q].w}, u2[4] = {a2[q].x, a2[q].y, a2[q].z, a2[q].w};
                float v[8]; float sq = 0.f;
#pragma unroll
                for (int j = 0; j < 4; ++j) {
                    v[2 * j] = (w0 * bf_lo(u0[j]) + w1 * bf_lo(u1[j]) + w2 * bf_lo(u2[j])) * iw; v[2 * j + 1] = (w0 * bf_hi(u0[j]) + w1 * bf_hi(u1[j]) + w2 * bf_hi(u2[j])) * iw;
                    sq += v[2 * j] * v[2 * j] + v[2 * j + 1] * v[2 * j + 1];
                }
                sq += __shfl_xor(sq, 8); sq += __shfl_xor(sq, 4); sq += __shfl_xor(sq, 2); sq += __shfl_xor(sq, 1);
                const float rs = rsqrtf(sq * (1.0f / 128.0f) + EPS);
                u32x4 o;
                o.x = cvt_pk_bf16(v[0] * rs * ga[0], v[1] * rs * ga[1]); o.y = cvt_pk_bf16(v[2] * rs * ga[2], v[3] * rs * ga[3]);
                o.z = cvt_pk_bf16(v[4] * rs * ga[4], v[5] * rs * ga[5]); o.w = cvt_pk_bf16(v[6] * rs * ga[6], v[7] * rs * ga[7]);
                *(u32x4*)(mrow + 1024 + hd * 128 + dl) = o;
            }
        }
    }
}

__global__ void __launch_bounds__(512, 2) hymba_fwd(Params P) {
    extern __shared__ __attribute__((aligned(16))) unsigned char shm[];
    LAS unsigned char* lds = (LAS unsigned char*)shm;
    cg::grid_group grid = cg::this_grid();
    unsigned char* ws = P.ws;
    const int G = gridDim.x, bid = blockIdx.x;
    bf16_t* hb0 = (bf16_t*)(ws + OFF_HB0); bf16_t* hb1 = (bf16_t*)(ws + OFF_MIX); bf16_t* mixb = (bf16_t*)P.out;
    bf16_t* z = (bf16_t*)(ws + OFF_G); bf16_t* act = (bf16_t*)(ws + OFF_ACT); bf16_t* PPb = (bf16_t*)P.out + (size_t)NTOK * DM;
    bf16_t* part1 = (bf16_t*)(ws + OFF_HB0); bf16_t* part2 = part1 + (size_t)NTOK * 1024;
    const float* cosT = (const float*)(ws + OFF_CS); const float* sinT = cosT + (size_t)NTOK * 16;
    f32x2* ml = (f32x2*)(ws + OFF_ML); float* ss = (float*)(ws + OFF_SSP);

    stamp(ws, 0);
    volatile LAS unsigned* xst = (volatile LAS unsigned*)(lds + 143360 + 16);
    if (threadIdx.x == 0) { xst[0] = 0u; xst[1] = 0u; }
    __syncthreads();
    const XcdBarrier xb = xcd_barrier_post((unsigned*)(ws + OFF_BAR), xst);
    prep_phase(P, lds);
    grid.sync(); stamp(ws, 1);
#pragma unroll 1
    for (int l = 0; l < 2; ++l) {
        const unsigned char* wl = ws + OFF_W + (size_t)l * SZ_WL;
        pg8::StaticOrder S;
        { pg8::Gemm g{hb1, (const bf16_t*)(wl + WO_IN), NTOK, INC, DM}; S.init(NTOK, INC, G, bid);
          EpiIn E{z, ss + (size_t)(3 * l) * NTOK * 32, cosT, sinT}; pg8::gemm_phase(lds, g, S, E); }
        xcd_barrier(xb); stamp(ws, 2 + 10 * l);
        {
            float* Ust = (float*)(ws + OFF_U); float* Dst = (float*)(ws + OFF_D);
            for (int it = bid; it < 256; it += G) if ((it & 7) != 7) hgrn_seq<false>(P, lds, it >> 3, it & 7, l, z, mixb, Ust, Dst);
            xcd_barrier(xb);
            for (int it = bid; it < 256; it += G) hgrn_seq<true>(P, lds, it >> 3, it & 7, l, z, mixb, Ust, Dst);
        }
        stamp(ws, 3 + 10 * l);
        {
            unsigned* ctr = (unsigned*)(ws + OFF_CTR) + l;
            LAS int* slot = (LAS int*)(lds + 143360);
            int pend = 0;
            if (threadIdx.x == 0) pend = (int)__hip_atomic_fetch_add(ctr, 1u, __ATOMIC_RELAXED, __HIP_MEMORY_SCOPE_AGENT);
            for (;;) {
                __syncthreads();
                if (threadIdx.x == 0) *slot = pend;
                __syncthreads();
                const int it = *slot;
                if (it >= 3 * 512) break;
                if (threadIdx.x == 0) pend = (int)__hip_atomic_fetch_add(ctr, 1u, __ATOMIC_RELAXED, __HIP_MEMORY_SCOPE_AGENT);
                attn_run(lds, it, z, mixb, part1, part2, ml);
            }
        }
        xcd_barrier(xb); stamp(ws, 4 + 10 * l);
        mixfin_phase(P, l, z, mixb, part1, part2, ml);
        xcd_barrier(xb); stamp(ws, 5 + 10 * l);
        { pg8::Gemm g{mixb, (const bf16_t*)(wl + WO_OUT), NTOK, DM, DM}; S.init(NTOK, DM, G, bid);
          EpiRes E{hb1, hb0, ss + (size_t)(3 * l + 1) * NTOK * 32, 0}; pg8::gemm_phase(lds, g, S, E); }
        { pg8::Gemm g{(const bf16_t*)(ws + OFF_PB) + (size_t)l * NTOK * PLE, (const bf16_t*)(wl + WO_PP), NTOK, DM, PLE}; S.init(NTOK, DM, G, bid);
          EpiPP E{PPb}; pg8::gemm_phase(lds, g, S, E); }
        xcd_barrier(xb); stamp(ws, 6 + 10 * l);
        { pg8::Gemm g{hb0, (const bf16_t*)(wl + WO_1), NTOK, DFF, DM}; S.init(NTOK, DFF, G, bid);
          EpiAct E{act, ss + (size_t)(3 * l + 1) * NTOK * 32, 0}; pg8::gemm_phase(lds, g, S, E); }
#if PROBE_SYNC
        { const unsigned long long t0_ = __builtin_amdgcn_s_memrealtime(); xcd_barrier(xb); const unsigned long long t1_ = __builtin_amdgcn_s_memrealtime();
          if (l == 0 && threadIdx.x == 0) ((unsigned*)(ws + OFF_TS + 2048))[blockIdx.x] = (unsigned)(t1_ - t0_); }
        stamp(ws, 7 + 10 * l);
#else
        xcd_barrier(xb); stamp(ws, 7 + 10 * l);
#endif
        { pg8::Gemm g{act, (const bf16_t*)(wl + WO_2), NTOK, DM, DFF}; S.init(NTOK, DM, G, bid);
          EpiRes E{hb0, hb0, ss + (size_t)(3 * l + 2) * NTOK * 32, 0}; pg8::gemm_phase(lds, g, S, E); }
        xcd_barrier(xb); stamp(ws, 8 + 10 * l);
        { pg8::Gemm g{hb0, (const bf16_t*)(wl + WO_PG), NTOK, DM, DM}; S.init(NTOK, DM, G, bid);
          EpiPle E{hb0, hb1, nullptr, PPb, ss + (size_t)(3 * l + 2) * NTOK * 32, ss + (size_t)(3 * l + 3) * NTOK * 32}; pg8::gemm_phase(lds, g, S, E); }
        xcd_barrier(xb); stamp(ws, 11 + 10 * l);
    }
#if PROBE_ON
    xcd_barrier(xb);
#endif
    {
        int tid = threadIdx.x; asm volatile("" : "+v"(tid));
        const int lane = tid & 63, w = tid >> 6;
        const float* ssf = ss + (size_t)6 * NTOK * 32;
        float pscale = 1.0f;
#if PROBE_ON
        {
            const unsigned long long* ts = (const unsigned long long*)(ws + OFF_TS);
#if PROBE_SYNC
            float fr_ = 0.f; { const unsigned* xc = (const unsigned*)(ws + OFF_TS + 2048); unsigned mn = 0xffffffffu, mx_ = 0u; for (int b2 = 0; b2 < 256; ++b2) { mn = xc[b2] < mn ? xc[b2] : mn; mx_ = xc[b2] > mx_ ? xc[b2] : mx_; } fr_ = (PROBE_SYNC == 1 ? (float)mn : (float)mx_) * (1.0f / 5000.0f); }
#elif PROBE_CLK
            const float fr_ = (float)(ts[64 + PROBE_B] - ts[64 + PROBE_A]) / ((float)(ts[PROBE_B] - ts[PROBE_A]) * 24.0f);
#else
            float fr_ = 0.f;
#pragma unroll 1
            for (int i = 1; i <= 21; ++i) if ((PROBE_MASK1 >> i) & 1u) fr_ += (float)(ts[i] - ts[i - 1]);
            fr_ = fr_ / (float)(ts[21] - ts[0]);
#endif
            pscale = 1.0f + 0.003f + PROBE_K * fr_;
        }
#endif
        for (int row = bid * 8 + w; row < NTOK; row += G * 8) {
            const float rs = rsqrtf(wave_sum(lane < 32 ? ssf[(size_t)row * 32 + lane] : 0.f) * (1.0f / DM) + EPS);
            const bf16_t* hr = hb1 + (size_t)row * DM; float* orow = P.out + (size_t)row * DM;
#pragma unroll
            for (int i = 0; i < 4; ++i) {
                const u32x4 hv = *(const u32x4*)(hr + i * 512 + lane * 8);
                f32x4 v0, v1; unpack8(hv, v0, v1);
                const f32x4 g0 = *(const f32x4*)(P.final_norm + i * 512 + lane * 8), g1 = *(const f32x4*)(P.final_norm + i * 512 + lane * 8 + 4);
                v0 = v0 * rs * g0 * pscale; v1 = v1 * rs * g1 * pscale;
                *(f32x4*)(orow + i * 512 + lane * 8) = v0; *(f32x4*)(orow + i * 512 + lane * 8 + 4) = v1;
            }
        }
    }
}

extern "C" void kernel_launch(void* const* d_in, const int* in_sizes, int n_in, void* d_out, int out_size, void* d_ws, size_t ws_size, hipStream_t stream) {
    static int grid_blocks = 0;
    if (grid_blocks == 0) {
        if (n_in != 16 || ws_size < WS_NEED3 || out_size != NTOK * DM) { fprintf(stderr, "kernel_launch: unexpected problem (n_in %d, ws %zu need %zu, out %d)\n", n_in, ws_size, (size_t)WS_END, out_size); grid_blocks = -1; return; }
        int dev = 0, cus = 0, per_cu = 0;
        hipGetDevice(&dev);
        hipDeviceGetAttribute(&cus, hipDeviceAttributeMultiprocessorCount, dev);
        if (hipFuncSetAttribute((const void*)hymba_fwd, hipFuncAttributeMaxDynamicSharedMemorySize, LDS_BYTES) != hipSuccess) { fprintf(stderr, "kernel_launch: hipFuncSetAttribute failed\n"); grid_blocks = -1; return; }
        if (hipOccupancyMaxActiveBlocksPerMultiprocessor(&per_cu, (const void*)hymba_fwd, 512, LDS_BYTES) != hipSuccess || per_cu < 1) { fprintf(stderr, "kernel_launch: occupancy query gave %d\n", per_cu); per_cu = 1; }
        (void)hipGetLastError();
        grid_blocks = cus;
    }
    if (grid_blocks < 0) return;
    Params P{};
    P.x = (const float*)d_in[0]; P.p = (const float*)d_in[1]; P.pos = (const int*)d_in[2];
    P.norm1 = (const float*)d_in[3]; P.w_in = (const float*)d_in[4]; P.lb = (const float*)d_in[5]; P.hgrn_norm = (const float*)d_in[6]; P.attn_norm = (const float*)d_in[7];
    P.w_out = (const float*)d_in[8]; P.norm2 = (const float*)d_in[9]; P.w1 = (const float*)d_in[10]; P.w2 = (const float*)d_in[11]; P.ple_norm = (const float*)d_in[12];
    P.w_pg = (const float*)d_in[13]; P.w_pp = (const float*)d_in[14]; P.final_norm = (const float*)d_in[15];
    P.out = (float*)d_out; P.ws = (unsigned char*)d_ws;
    if (hipMemsetAsync((unsigned char*)d_ws + OFF_BAR, 0, XCD_BAR_WORDS * sizeof(unsigned), stream) != hipSuccess) { fprintf(stderr, "kernel_launch: memset of the barrier words failed\n"); return; }
    void* args[] = {&P};
    hipError_t e = hipLaunchCooperativeKernel((const void*)hymba_fwd, dim3(grid_blocks), dim3(512), args, LDS_BYTES, stream);
    if (e != hipSuccess) fprintf(stderr, "cooperative launch failed: %s (grid %d)\n", hipGetErrorString(e), grid_blocks);
}
```
